# Optimizing an MI355X kernel written in HIP

```python
import jax, jax.numpy as jnp
from jax import lax
import numpy as np

D_MODEL = 4096
BATCH = 4
SEQ = 2048
DEPTH = 1

SG_WIDTH = 2048
SG_GROUPS = 8
SG_GROUP_DIM = SG_WIDTH // SG_GROUPS
CHUNK = 128
LRU_WIDTH = 4096
LRU_HEADS = 16
LRU_HEAD_DIM = LRU_WIDTH // LRU_HEADS
LRU_CONV = 4
LRU_C = 8.0
FFN_WIDTH = 3 * D_MODEL
FFN_CONV = 3
EPS = 1e-6
IN_SPLITS = [SG_WIDTH, 2 * SG_WIDTH, 2 * SG_WIDTH + LRU_WIDTH, 2 * SG_WIDTH + 2 * LRU_WIDTH,
             2 * SG_WIDTH + 2 * LRU_WIDTH + D_MODEL]
IN_COLS = 2 * SG_WIDTH + 2 * LRU_WIDTH + 2 * D_MODEL

kernel_name = "hybrid_gmlp_rglru_gated_merge"


def rmsnorm(x, g):
    xf = x.astype(jnp.float32)
    var = jnp.mean(xf * xf, axis=-1, keepdims=True)
    return (xf * lax.rsqrt(var + EPS) * g.astype(jnp.float32)).astype(x.dtype)


def layernorm(x, g, b):
    xf = x.astype(jnp.float32)
    mu = jnp.mean(xf, axis=-1, keepdims=True)
    xc = xf - mu
    var = jnp.mean(xc * xc, axis=-1, keepdims=True)
    return (xc * lax.rsqrt(var + EPS) * g.astype(jnp.float32) + b.astype(jnp.float32)).astype(x.dtype)


def causal_dwconv(x, w, b):
    K = w.shape[0]
    S = x.shape[1]
    xp = jnp.pad(x, ((0, 0), (K - 1, 0), (0, 0)))
    w = w.astype(x.dtype)
    out = xp[:, 0:S] * w[0]
    for k in range(1, K):
        out = out + xp[:, k:k + S] * w[k]
    return out + b.astype(x.dtype)


def spatial_gating(u, v, ln_g, ln_b, w_s, b_s):
    B, S, _ = u.shape
    vn = layernorm(v, ln_g, ln_b).reshape(B, S // CHUNK, CHUNK, SG_GROUPS, SG_GROUP_DIM)
    mask = jnp.tril(jnp.ones((CHUNK, CHUNK), dtype=bool))
    w = jnp.where(mask, w_s, 0.0).astype(vn.dtype)
    mixed = jnp.einsum('gts,bcsgd->bctgd', w, vn) + b_s.T.astype(vn.dtype)[:, :, None]
    return u * mixed.reshape(B, S, SG_WIDTH)


def rg_lru(x, w_a, b_a, w_x, b_x, lam):
    B, S, W = x.shape
    xf = x.astype(jnp.float32)
    xh = xf.reshape(B, S, LRU_HEADS, LRU_HEAD_DIM)
    rec_gate = jax.nn.sigmoid(jnp.einsum('bshi,hij->bshj', xh, w_a.astype(jnp.float32)).reshape(B, S, W)
                              + b_a.astype(jnp.float32))
    in_gate = jax.nn.sigmoid(jnp.einsum('bshi,hij->bshj', xh, w_x.astype(jnp.float32)).reshape(B, S, W)
                             + b_x.astype(jnp.float32))
    log_a = -LRU_C * rec_gate * jax.nn.softplus(-lam.astype(jnp.float32))
    a = jnp.exp(log_a)
    gated_x = jnp.sqrt(-jnp.expm1(2.0 * log_a)) * (in_gate * xf)

    def combine(left, right):
        a1, b1 = left
        a2, b2 = right
        return a1 * a2, a2 * b1 + b2

    _, h = lax.associative_scan(combine, (a, gated_x), axis=1)
    return h.astype(x.dtype)


def hybrid_layer(x, g_mix, w_in, sg_ln_g, sg_ln_b, sg_w, sg_b, lru_conv_w, lru_conv_b,
                 lru_wa, lru_ba, lru_wx, lru_bx, lru_lam, p_sg, p_lru, w_out,
                 g_ffn, w_up, ffn_conv_w, ffn_conv_b, w_down):
    h = rmsnorm(x, g_mix)
    proj = h @ w_in.astype(h.dtype)
    z_u, z_v, x_r, y_r, gate_a, gate_b = jnp.split(proj, IN_SPLITS, axis=-1)
    y_a = spatial_gating(jax.nn.gelu(z_u), jax.nn.gelu(z_v), sg_ln_g, sg_ln_b, sg_w, sg_b)
    x_r = causal_dwconv(x_r, lru_conv_w, lru_conv_b)
    y_b = rg_lru(x_r, lru_wa, lru_ba, lru_wx, lru_bx, lru_lam) * jax.nn.gelu(y_r)
    merged = (jax.nn.sigmoid(gate_a) * (y_a @ p_sg.astype(y_a.dtype))
              + jax.nn.sigmoid(gate_b) * (y_b @ p_lru.astype(y_b.dtype)))
    x = x + merged @ w_out.astype(merged.dtype)
    h = rmsnorm(x, g_ffn)
    up = causal_dwconv(h @ w_up.astype(h.dtype), ffn_conv_w, ffn_conv_b)
    c_gate, c_val = jnp.split(up, 2, axis=-1)
    x = x + (jax.nn.gelu(c_gate) * c_val) @ w_down.astype(up.dtype)
    return x


def setup_inputs(seed: int = 0) -> dict:
    key = jax.random.key(seed)
    ks = jax.random.split(key, 24)
    f32 = jnp.float32
    L = DEPTH

    def nrm(k, shape, scale):
        return jax.random.normal(k, shape, f32) * scale

    a0 = jax.random.uniform(ks[14], (L, LRU_WIDTH), f32, 0.9, 0.999)
    p = a0 ** (1.0 / LRU_C)
    lru_lam = jnp.log(p) - jnp.log1p(-p)
    return {
        "x": nrm(ks[0], (BATCH, SEQ, D_MODEL), 1.0),
        "g_mix": 1.0 + nrm(ks[1], (L, D_MODEL), 0.02),
        "w_in": nrm(ks[2], (L, D_MODEL, IN_COLS), D_MODEL ** -0.5),
        "sg_ln_g": 1.0 + nrm(ks[3], (L, SG_WIDTH), 0.02),
        "sg_ln_b": nrm(ks[4], (L, SG_WIDTH), 0.02),
        "sg_w": nrm(ks[5], (L, SG_GROUPS, CHUNK, CHUNK), CHUNK ** -0.5),
        "sg_b": 1.0 + nrm(ks[6], (L, SG_GROUPS, CHUNK), 0.02),
        "lru_conv_w": nrm(ks[7], (L, LRU_CONV, LRU_WIDTH), LRU_CONV ** -0.5),
        "lru_conv_b": nrm(ks[8], (L, LRU_WIDTH), 0.02),
        "lru_wa": nrm(ks[9], (L, LRU_HEADS, LRU_HEAD_DIM, LRU_HEAD_DIM), LRU_HEAD_DIM ** -0.5),
        "lru_ba": nrm(ks[10], (L, LRU_WIDTH), 0.02),
        "lru_wx": nrm(ks[11], (L, LRU_HEADS, LRU_HEAD_DIM, LRU_HEAD_DIM), LRU_HEAD_DIM ** -0.5),
        "lru_bx": nrm(ks[12], (L, LRU_WIDTH), 0.02),
        "lru_lam": lru_lam,
        "p_sg": nrm(ks[15], (L, SG_WIDTH, D_MODEL), SG_WIDTH ** -0.5),
        "p_lru": nrm(ks[16], (L, LRU_WIDTH, D_MODEL), LRU_WIDTH ** -0.5),
        "w_out": nrm(ks[17], (L, D_MODEL, D_MODEL), D_MODEL ** -0.5),
        "g_ffn": 1.0 + nrm(ks[18], (L, D_MODEL), 0.02),
        "w_up": nrm(ks[19], (L, D_MODEL, 2 * FFN_WIDTH), D_MODEL ** -0.5),
        "ffn_conv_w": nrm(ks[20], (L, FFN_CONV, 2 * FFN_WIDTH), FFN_CONV ** -0.5),
        "ffn_conv_b": nrm(ks[21], (L, 2 * FFN_WIDTH), 0.02),
        "w_down": nrm(ks[22], (L, FFN_WIDTH, D_MODEL), FFN_WIDTH ** -0.5),
        "g_final": 1.0 + nrm(ks[23], (D_MODEL,), 0.02),
    }


def reference(x, g_mix, w_in, sg_ln_g, sg_ln_b, sg_w, sg_b, lru_conv_w, lru_conv_b,
              lru_wa, lru_ba, lru_wx, lru_bx, lru_lam, p_sg, p_lru, w_out,
              g_ffn, w_up, ffn_conv_w, ffn_conv_b, w_down, g_final):
    for l in range(DEPTH):
        x = hybrid_layer(x, g_mix[l], w_in[l], sg_ln_g[l], sg_ln_b[l], sg_w[l], sg_b[l],
                         lru_conv_w[l], lru_conv_b[l], lru_wa[l], lru_ba[l], lru_wx[l], lru_bx[l],
                         lru_lam[l], p_sg[l], p_lru[l], w_out[l], g_ffn[l], w_up[l],
                         ffn_conv_w[l], ffn_conv_b[l], w_down[l])
    return rmsnorm(x, g_final)
```

```cpp
#include <hip/hip_runtime.h>
#include <cstdio>
#include <cstdint>

#ifndef MK_N_LAUNCHES
#define MK_N_LAUNCHES 9
#endif

namespace pg8 {
#define PG8_LAS __attribute__((address_space(3)))
typedef unsigned short bf16_t;
typedef short bf16x8 __attribute__((ext_vector_type(8)));
typedef float f32x4 __attribute__((ext_vector_type(4)));
typedef unsigned u32x4 __attribute__((ext_vector_type(4)));
typedef unsigned u32x2 __attribute__((ext_vector_type(2)));
constexpr int BM = 256, BK = 64, HALF = 128, HTB = HALF * BK * 2  , STAGE_BYTES = 8 * HTB, NXCD = 8, WGM = 8;

__host__ __device__ __forceinline__ int lds_byte(int r, int c) { const int st = (r >> 4) * 2 + (c >> 5), rr = r & 15, cc = c & 31, ob = rr * 64 + cc * 2; return st * 1024 + (ob ^ (((ob >> 9) & 1) << 5)); }
__host__ __device__ __forceinline__ void stage_rc(int b, int& R, int& C) { const int st = b / 1024, sb = b % 1024, swz = sb ^ (((sb >> 9) & 1) << 5); R = (st >> 1) * 16 + swz / 64; C = (st & 1) * 32 + (swz % 64) / 2; }
__host__ __device__ __forceinline__ int perm32(int rho) { const int n = rho >> 4, i = rho & 15; return 8 * (i >> 2) + 4 * n + (i & 3); }

struct Unit { int pm, pn; };
struct Gemm { const bf16_t* A; const bf16_t* Bt; int M, N, K; };

struct StaticOrder {
    int nM, nN, nwg, G, c;
    __host__ __device__ void init(int M, int N, int G_, int c_) { nM = M / BM; nN = N / BM; nwg = nM * nN; G = G_; c = c_; }
    __host__ __device__ bool next(int i, Unit& u) const {
        const long L = (long)i * G + c; if (L >= nwg) return false;
        int wgid = (int)L; { const int q = nwg / NXCD, r = nwg % NXCD, xcd = wgid % NXCD, off = wgid / NXCD; wgid = (xcd < r ? xcd * (q + 1) : r * (q + 1) + (xcd - r) * q) + off; }
        const int nig = WGM * nN, gid = wgid / nig, fm = gid * WGM, gsz = (nM - fm) < WGM ? (nM - fm) : WGM;
        u.pm = fm + ((wgid % nig) % gsz); u.pn = (wgid % nig) / gsz; return true;
    }
    __device__ __forceinline__ void a_ready(const Unit&) const {}
    __device__ __forceinline__ void done(const Unit&) const {}
};

__device__ __forceinline__ unsigned cvt_pk_bf16(float lo, float hi) { unsigned r; asm volatile("v_cvt_pk_bf16_f32 %0, %1, %2" : "=v"(r) : "v"(lo), "v"(hi)); return r; }
__device__ __forceinline__ float bf_lo(unsigned w) { return __uint_as_float(w << 16); }
__device__ __forceinline__ float bf_hi(unsigned w) { return __uint_as_float(w & 0xffff0000u); }
__device__ __forceinline__ float sigmoid_f(float z) { return __builtin_amdgcn_rcpf(1.0f + __builtin_amdgcn_exp2f(-1.4426950409f * z)); }
__device__ __forceinline__ float gelu_tanh_f(float v) { const float z = 1.5957691216f * (v + 0.044715f * v * v * v); return v * sigmoid_f(z); }


struct EpiProj {
    static constexpr bool PERM = true, AFTER_DRAIN = false;
    bf16_t *GU, *GV, *XR, *GYR, *SGA, *SGB; float *vsum, *vsq;
    __device__ __forceinline__ void operator()(const f32x4 (&acc)[2][2][4][2], const Unit& u, int wr, int wc, int fr, int fq) const {
        const int pn = u.pn; bf16_t* base; int ldc, colt, act;
        if (pn < 8)       { base = GU;  ldc = 2048; colt = pn * 256;        act = 1; }
        else if (pn < 16) { base = GV;  ldc = 2048; colt = (pn - 8) * 256;  act = 1; }
        else if (pn < 32) { base = XR;  ldc = 4096; colt = (pn - 16) * 256; act = 0; }
        else if (pn < 48) { base = GYR; ldc = 4096; colt = (pn - 32) * 256; act = 1; }
        else if (pn < 64) { base = SGA; ldc = 4096; colt = (pn - 48) * 256; act = 2; }
        else              { base = SGB; ldc = 4096; colt = (pn - 64) * 256; act = 2; }
        const bool st = (pn >= 8) && (pn < 16);
        const int row0 = u.pm * BM + wr * 64 + fr, col0 = colt + wc * 32 + 8 * fq;
#pragma unroll
        for (int ai = 0; ai < 2; ++ai)
#pragma unroll
            for (int m = 0; m < 4; ++m) { const int row = row0 + ai * HALF + m * 16; bf16_t* rowp = base + (size_t)row * ldc + col0; float s = 0.f, q = 0.f;
#pragma unroll
                for (int bj = 0; bj < 2; ++bj) { f32x4 v0 = acc[ai][bj][m][0], v1 = acc[ai][bj][m][1];
                    if (act == 1) {
#pragma unroll
                        for (int j = 0; j < 4; ++j) { v0[j] = gelu_tanh_f(v0[j]); v1[j] = gelu_tanh_f(v1[j]); } }
                    else if (act == 2) {
#pragma unroll
                        for (int j = 0; j < 4; ++j) { v0[j] = sigmoid_f(v0[j]); v1[j] = sigmoid_f(v1[j]); } }
                    if (st) {
#pragma unroll
                        for (int j = 0; j < 4; ++j) { s += v0[j] + v1[j]; q += v0[j] * v0[j] + v1[j] * v1[j]; } }
                    u32x4 w; w.x = cvt_pk_bf16(v0[0], v0[1]); w.y = cvt_pk_bf16(v0[2], v0[3]); w.z = cvt_pk_bf16(v1[0], v1[1]); w.w = cvt_pk_bf16(v1[2], v1[3]);
                    *(u32x4*)(rowp + bj * HALF) = w; }
                if (st) { s += __shfl_xor(s, 16); s += __shfl_xor(s, 32); q += __shfl_xor(q, 16); q += __shfl_xor(q, 32);
                    if (fq == 0) { unsafeAtomicAdd(vsum + row, s); unsafeAtomicAdd(vsq + row, q); } } }
    }
};
struct EpiPA {
    static constexpr bool PERM = true, AFTER_DRAIN = false;
    const bf16_t* SG; float* M1;
    __device__ __forceinline__ void operator()(const f32x4 (&acc)[2][2][4][2], const Unit& u, int wr, int wc, int fr, int fq) const {
        const int row0 = u.pm * BM + wr * 64 + fr, col0 = u.pn * BM + wc * 32 + 8 * fq;
#pragma unroll
        for (int ai = 0; ai < 2; ++ai)
#pragma unroll
            for (int m = 0; m < 4; ++m) { const size_t off = (size_t)(row0 + ai * HALF + m * 16) * 4096 + col0;
#pragma unroll
                for (int bj = 0; bj < 2; ++bj) { const u32x4 g = *(const u32x4*)(SG + off + bj * HALF); const f32x4 a0 = acc[ai][bj][m][0], a1 = acc[ai][bj][m][1];
                    f32x4 o0, o1; o0[0] = a0[0] * bf_lo(g.x); o0[1] = a0[1] * bf_hi(g.x); o0[2] = a0[2] * bf_lo(g.y); o0[3] = a0[3] * bf_hi(g.y);
                    o1[0] = a1[0] * bf_lo(g.z); o1[1] = a1[1] * bf_hi(g.z); o1[2] = a1[2] * bf_lo(g.w); o1[3] = a1[3] * bf_hi(g.w);
                    *(f32x4*)(M1 + off + bj * HALF) = o0; *(f32x4*)(M1 + off + bj * HALF + 4) = o1; } }
    }
};
struct EpiPB {
    static constexpr bool PERM = true, AFTER_DRAIN = false;
    const bf16_t* SG; const float* M1; bf16_t* O;
    __device__ __forceinline__ void operator()(const f32x4 (&acc)[2][2][4][2], const Unit& u, int wr, int wc, int fr, int fq) const {
        const int row0 = u.pm * BM + wr * 64 + fr, col0 = u.pn * BM + wc * 32 + 8 * fq;
#pragma unroll
        for (int ai = 0; ai < 2; ++ai)
#pragma unroll
            for (int m = 0; m < 4; ++m) { const size_t off = (size_t)(row0 + ai * HALF + m * 16) * 4096 + col0;
#pragma unroll
                for (int bj = 0; bj < 2; ++bj) { const u32x4 g = *(const u32x4*)(SG + off + bj * HALF); const f32x4 a0 = acc[ai][bj][m][0], a1 = acc[ai][bj][m][1];
                    const f32x4 p0 = *(const f32x4*)(M1 + off + bj * HALF), p1 = *(const f32x4*)(M1 + off + bj * HALF + 4);
                    u32x4 w; w.x = cvt_pk_bf16(p0[0] + a0[0] * bf_lo(g.x), p0[1] + a0[1] * bf_hi(g.x)); w.y = cvt_pk_bf16(p0[2] + a0[2] * bf_lo(g.y), p0[3] + a0[3] * bf_hi(g.y));
                    w.z = cvt_pk_bf16(p1[0] + a1[0] * bf_lo(g.z), p1[1] + a1[1] * bf_hi(g.z)); w.w = cvt_pk_bf16(p1[2] + a1[2] * bf_lo(g.w), p1[3] + a1[3] * bf_hi(g.w));
                    *(u32x4*)(O + off + bj * HALF) = w; } }
    }
};
template <bool WITH_B> struct EpiResid {
    static constexpr bool PERM = true, AFTER_DRAIN = false;
    const float* XI; float* XO; bf16_t* XB; const float* gain; float* rowss;
    __device__ __forceinline__ void operator()(const f32x4 (&acc)[2][2][4][2], const Unit& u, int wr, int wc, int fr, int fq) const {
        const int row0 = u.pm * BM + wr * 64 + fr, col0 = u.pn * BM + wc * 32 + 8 * fq;
        f32x4 gv[2][2];
        if (WITH_B) {
#pragma unroll
            for (int bj = 0; bj < 2; ++bj) { gv[bj][0] = *(const f32x4*)(gain + col0 + bj * HALF); gv[bj][1] = *(const f32x4*)(gain + col0 + bj * HALF + 4); } }
#pragma unroll
        for (int ai = 0; ai < 2; ++ai)
#pragma unroll
            for (int m = 0; m < 4; ++m) { const int row = row0 + ai * HALF + m * 16; const size_t off = (size_t)row * 4096 + col0; float q = 0.f;
#pragma unroll
                for (int bj = 0; bj < 2; ++bj) { const f32x4 x0 = *(const f32x4*)(XI + off + bj * HALF) + acc[ai][bj][m][0], x1 = *(const f32x4*)(XI + off + bj * HALF + 4) + acc[ai][bj][m][1];
                    *(f32x4*)(XO + off + bj * HALF) = x0; *(f32x4*)(XO + off + bj * HALF + 4) = x1;
#pragma unroll
                    for (int j = 0; j < 4; ++j) q += x0[j] * x0[j] + x1[j] * x1[j];
                    if (WITH_B) { const f32x4 y0 = x0 * gv[bj][0], y1 = x1 * gv[bj][1]; u32x4 w; w.x = cvt_pk_bf16(y0[0], y0[1]); w.y = cvt_pk_bf16(y0[2], y0[3]); w.z = cvt_pk_bf16(y1[0], y1[1]); w.w = cvt_pk_bf16(y1[2], y1[3]);
                        *(u32x4*)(XB + off + bj * HALF) = w; } }
                q += __shfl_xor(q, 16); q += __shfl_xor(q, 32);
                if (fq == 0) unsafeAtomicAdd(rowss + row, q); }
    }
};
struct EpiUp {
    static constexpr bool PERM = true, AFTER_DRAIN = false;
    bf16_t* UP; const float* rowss;
    __device__ __forceinline__ void operator()(const f32x4 (&acc)[2][2][4][2], const Unit& u, int wr, int wc, int fr, int fq) const {
        const int row0 = u.pm * BM + wr * 64 + fr, col0 = u.pn * BM + wc * 32 + 8 * fq;
#pragma unroll
        for (int ai = 0; ai < 2; ++ai)
#pragma unroll
            for (int m = 0; m < 4; ++m) { const int row = row0 + ai * HALF + m * 16; const float rs = 1.0f / sqrtf(rowss[row] * (1.0f / 4096.0f) + 1e-6f); bf16_t* rowp = UP + (size_t)row * 24576 + col0;
#pragma unroll
                for (int bj = 0; bj < 2; ++bj) { const f32x4 v0 = acc[ai][bj][m][0] * rs, v1 = acc[ai][bj][m][1] * rs;
                    u32x4 w; w.x = cvt_pk_bf16(v0[0], v0[1]); w.y = cvt_pk_bf16(v0[2], v0[3]); w.z = cvt_pk_bf16(v1[0], v1[1]); w.w = cvt_pk_bf16(v1[2], v1[3]);
                    *(u32x4*)(rowp + bj * HALF) = w; } }
    }
};

template <class Epi, class Sched, bool ALIGN_EPI = false, bool SP2 = false>
__device__ __forceinline__ void gemm_phase(PG8_LAS unsigned char* lds, const Gemm g, const Sched& S, const Epi& E) {
    int tid = threadIdx.x; asm volatile("" : "+v"(tid));
    const int wid = __builtin_amdgcn_readfirstlane(tid >> 6), lane = tid & 63, wr = wid >> 2, wc = wid & 3, fr = lane & 15, fq = lane >> 4;
    const int K = g.K, nt = K / BK;
    unsigned voffA[2], voffB[2];
#pragma unroll
    for (int i = 0; i < 2; ++i) { int R, C; stage_rc(tid * 16 + i * 8192, R, C); const int Rb = Epi::PERM ? ((R & ~31) + perm32(R & 31)) : R;
        voffA[i] = (unsigned)(R * K + C) * 2u; voffB[i] = (unsigned)(Rb * K + C) * 2u; }
    const size_t kstep = (size_t)(BK * 2);
    const size_t hstep = (size_t)HALF * K * 2;
    const size_t tstep = 2 * hstep;
    const unsigned ldsw = (unsigned)wid * 1024u;
    const int aoff = lds_byte(wr * 64 + fr, fq * 8), boff = lds_byte(wc * 32 + fr, fq * 8);
#define PG8_SA(b, h) (((b) * 2 + (h)) * HTB)
#define PG8_SB(b, h) ((4 + (b) * 2 + (h)) * HTB)
#define PG8_STAGE(bufoff, gbase, voff) do { _Pragma("unroll") for (int _i = 0; _i < 2; ++_i) \
        __builtin_amdgcn_global_load_lds((const unsigned*)((const char*)(gbase) + (voff)[_i]), (PG8_LAS unsigned*)(lds + (bufoff) + ldsw + _i * 8192), 16, 0, 0); } while (0)
#define PG8_LDA(dst, b, h) do { _Pragma("unroll") for (int m = 0; m < 4; ++m) _Pragma("unroll") for (int k = 0; k < 2; ++k) dst[m][k] = *(const PG8_LAS bf16x8*)(lds + PG8_SA(b, h) + aoff + m * 2048 + k * 1024); } while (0)
#define PG8_LDB(dst, b, h) do { _Pragma("unroll") for (int n = 0; n < 2; ++n) _Pragma("unroll") for (int k = 0; k < 2; ++k) dst[n][k] = *(const PG8_LAS bf16x8*)(lds + PG8_SB(b, h) + boff + n * 2048 + k * 1024); } while (0)
#define PG8_MMA(ai, bj, At, Bt) do { __builtin_amdgcn_s_setprio(1); _Pragma("unroll") for (int m = 0; m < 4; ++m) _Pragma("unroll") for (int n = 0; n < 2; ++n) _Pragma("unroll") for (int k = 0; k < 2; ++k) \
        acc[ai][bj][m][n] = __builtin_amdgcn_mfma_f32_16x16x32_bf16(Bt[n][k], At[m][k], acc[ai][bj][m][n], 0, 0, 0); __builtin_amdgcn_s_setprio(0); } while (0)
#define PG8_WAIT_V(n) asm volatile("s_waitcnt vmcnt(" #n ")" ::: "memory")
#define PG8_WAIT_L(n) asm volatile("s_waitcnt lgkmcnt(" #n ")" ::: "memory")
#define PG8_BAR __builtin_amdgcn_s_barrier()
#define PG8_SCHED __builtin_amdgcn_sched_barrier(0)
    Unit cur, nxt; int ui = 0;
    if (!S.next(0, cur)) return;
    f32x4 acc[2][2][4][2];
#pragma unroll
    for (int a = 0; a < 2; ++a)
#pragma unroll
        for (int b = 0; b < 2; ++b)
#pragma unroll
            for (int m = 0; m < 4; ++m)
#pragma unroll
                for (int n = 0; n < 2; ++n) acc[a][b][m][n] = (f32x4){0.f, 0.f, 0.f, 0.f};
    bf16x8 At[4][2], B0[2][2], B1[2][2];
    const char* cA = (const char*)g.A + (size_t)cur.pm * tstep; const char* cB = (const char*)g.Bt + (size_t)cur.pn * tstep;
    S.a_ready(cur);
    if constexpr (SP2) {
        PG8_STAGE(PG8_SB(0, 0), cB, voffB); PG8_STAGE(PG8_SB(0, 1), cB + hstep, voffB); PG8_STAGE(PG8_SA(0, 0), cA, voffA); PG8_STAGE(PG8_SA(0, 1), cA + hstep, voffA);
        if (wr == 1) PG8_BAR;
        PG8_WAIT_V(2); PG8_BAR;
        PG8_STAGE(PG8_SB(1, 0), cB + kstep, voffB); PG8_STAGE(PG8_SA(1, 0), cA + kstep, voffA); PG8_STAGE(PG8_SB(1, 1), cB + hstep + kstep, voffB);
        PG8_WAIT_V(6); PG8_BAR;
    } else {
        PG8_STAGE(PG8_SB(0, 0), cB, voffB); PG8_STAGE(PG8_SA(0, 0), cA, voffA); PG8_STAGE(PG8_SB(0, 1), cB + hstep, voffB); PG8_STAGE(PG8_SA(0, 1), cA + hstep, voffA);
        if (wr == 1) PG8_BAR;
        PG8_WAIT_V(4); PG8_BAR;
        PG8_STAGE(PG8_SB(1, 0), cB + kstep, voffB); PG8_STAGE(PG8_SA(1, 0), cA + kstep, voffA); PG8_STAGE(PG8_SB(1, 1), cB + hstep + kstep, voffB);
        PG8_WAIT_V(6); PG8_BAR;
    }
    for (;;) {
        const bool has_next = S.next(ui + 1, nxt);
        const char* nA = has_next ? (const char*)g.A + (size_t)nxt.pm * tstep : cA; const char* nB = has_next ? (const char*)g.Bt + (size_t)nxt.pn * tstep : cB;
        for (int t = 0; t < nt; t += 2) {
            const bool last = (t == nt - 2);
            const char* a1 = cA + (size_t)(t + 1) * kstep;
            const char* a2 = last ? nA : cA + (size_t)(t + 2) * kstep; const char* b2 = last ? nB : cB + (size_t)(t + 2) * kstep;
            const char* a3 = a2 + kstep; const char* b3 = b2 + kstep;
            if (last && has_next) S.a_ready(nxt);
            if constexpr (SP2) {
            PG8_LDB(B0, 0, 0); PG8_LDB(B1, 0, 1); PG8_SCHED; PG8_LDA(At, 0, 0); PG8_STAGE(PG8_SA(1, 1), a1 + hstep, voffA);
            PG8_WAIT_V(8); PG8_WAIT_L(0); PG8_BAR; PG8_MMA(0, 0, At, B0); PG8_MMA(0, 1, At, B1); PG8_BAR; PG8_SCHED;
            PG8_LDA(At, 0, 1); PG8_STAGE(PG8_SB(0, 0), b2, voffB); PG8_STAGE(PG8_SB(0, 1), b2 + hstep, voffB); PG8_STAGE(PG8_SA(0, 0), a2, voffA);
            PG8_WAIT_V(8); PG8_WAIT_L(0); PG8_BAR; PG8_MMA(1, 0, At, B0); PG8_MMA(1, 1, At, B1); PG8_BAR; PG8_SCHED;
            PG8_LDB(B0, 1, 0); PG8_LDB(B1, 1, 1); PG8_SCHED; PG8_LDA(At, 1, 0); PG8_STAGE(PG8_SA(0, 1), a2 + hstep, voffA);
            PG8_WAIT_V(8); PG8_WAIT_L(0); PG8_BAR; PG8_MMA(0, 0, At, B0); PG8_MMA(0, 1, At, B1); PG8_BAR; PG8_SCHED;
            PG8_LDA(At, 1, 1); PG8_STAGE(PG8_SB(1, 0), b3, voffB); PG8_STAGE(PG8_SB(1, 1), b3 + hstep, voffB); PG8_STAGE(PG8_SA(1, 0), a3, voffA);
            PG8_WAIT_V(8); PG8_WAIT_L(0); PG8_BAR; PG8_MMA(1, 0, At, B0); PG8_MMA(1, 1, At, B1); PG8_BAR; PG8_SCHED;
            } else {
            PG8_LDB(B0, 0, 0); PG8_SCHED; PG8_LDA(At, 0, 0); PG8_STAGE(PG8_SA(1, 1), a1 + hstep, voffA);
            PG8_WAIT_L(8); PG8_BAR; PG8_WAIT_L(0); PG8_MMA(0, 0, At, B0); PG8_BAR; PG8_SCHED;
            PG8_LDB(B1, 0, 1); PG8_STAGE(PG8_SB(0, 0), b2, voffB);
            PG8_BAR; PG8_WAIT_L(0); PG8_MMA(0, 1, At, B1); PG8_BAR;
            PG8_LDA(At, 0, 1); PG8_STAGE(PG8_SA(0, 0), a2, voffA);
            PG8_BAR; PG8_WAIT_L(0); PG8_MMA(1, 0, At, B0); PG8_BAR; PG8_SCHED;
            PG8_STAGE(PG8_SB(0, 1), b2 + hstep, voffB);
            PG8_WAIT_V(6); PG8_BAR; PG8_MMA(1, 1, At, B1); PG8_BAR;
            PG8_LDB(B0, 1, 0); PG8_SCHED; PG8_LDA(At, 1, 0); PG8_STAGE(PG8_SA(0, 1), a2 + hstep, voffA);
            PG8_WAIT_L(8); PG8_BAR; PG8_WAIT_L(0); PG8_MMA(0, 0, At, B0); PG8_BAR; PG8_SCHED;
            PG8_LDB(B1, 1, 1); PG8_STAGE(PG8_SB(1, 0), b3, voffB);
            PG8_BAR; PG8_WAIT_L(0); PG8_MMA(0, 1, At, B1); PG8_BAR;
            PG8_LDA(At, 1, 1); PG8_STAGE(PG8_SA(1, 0), a3, voffA);
            PG8_BAR; PG8_WAIT_L(0); PG8_MMA(1, 0, At, B0); PG8_BAR; PG8_SCHED;
            PG8_STAGE(PG8_SB(1, 1), b3 + hstep, voffB);
            PG8_WAIT_V(6); PG8_BAR; PG8_MMA(1, 1, At, B1); PG8_BAR;
            }
        }
        if constexpr (ALIGN_EPI) { if (wr == 0) PG8_BAR; }
        E(acc, cur, wr, wc, fr, fq); S.done(cur);
        if (!has_next) break;
#pragma unroll
        for (int a = 0; a < 2; ++a)
#pragma unroll
            for (int b = 0; b < 2; ++b)
#pragma unroll
                for (int m = 0; m < 4; ++m)
#pragma unroll
                    for (int n = 0; n < 2; ++n) acc[a][b][m][n] = (f32x4){0.f, 0.f, 0.f, 0.f};
        cur = nxt; cA = nA; cB = nB; ++ui;
        if constexpr (ALIGN_EPI) { if (wr == 1) PG8_BAR; }
    }
    PG8_WAIT_V(0);
    if constexpr (!ALIGN_EPI) { if (wr == 0) PG8_BAR; }
    PG8_BAR;
#undef PG8_SA
#undef PG8_SB
#undef PG8_STAGE
#undef PG8_LDA
#undef PG8_LDB
#undef PG8_MMA
#undef PG8_WAIT_V
#undef PG8_WAIT_L
#undef PG8_BAR
#undef PG8_SCHED
}
}

#ifndef PG8_SP2
#define PG8_SP2 true
#endif
#ifndef PG8_ALIGN
#define PG8_ALIGN true
#endif

constexpr int NWAVES = 8;
constexpr int N_LAUNCHES = MK_N_LAUNCHES;
constexpr int NPH = 9;
constexpr int DM = 4096, SEQ = 2048, NB = 4, M = NB * SEQ;
constexpr int SGW = 2048, SGD = 256, CHUNK = 128;
constexpr int LW = 4096, LH = 16, LHD = 256;
constexpr int FFW = 12288, UPN = 2 * FFW, INC = 20480;
constexpr float EPS = 1e-6f;

constexpr size_t MiB = 1u << 20;
constexpr size_t WS_CTL = 0, CTL_ZERO_BYTES = 1 * MiB;
constexpr size_t WS_WIN = 2 * MiB, WS_WUP = 162 * MiB, WS_WDN = 354 * MiB, WS_PA = 450 * MiB, WS_PB = 466 * MiB, WS_WOUT = 498 * MiB, WS_WA = 530 * MiB, WS_WX = 532 * MiB;
constexpr size_t WS_H = 536 * MiB, WS_GU = 600 * MiB, WS_GV = 632 * MiB, WS_XR = 664 * MiB, WS_GYR = 728 * MiB, WS_SGA = 792 * MiB, WS_SGB = 856 * MiB;
constexpr size_t WS_YA = 920 * MiB, WS_YB = 952 * MiB, WS_M1 = 1016 * MiB, WS_MRG = 1144 * MiB, WS_X1 = 1208 * MiB, WS_X1B = 1336 * MiB, WS_END = 1400 * MiB;
constexpr size_t WS_UP = 536 * MiB;
constexpr size_t WS_G = 920 * MiB;
static_assert(WS_UP + (size_t)M * UPN * 2 <= WS_YA && WS_G + (size_t)M * FFW * 2 <= WS_MRG, "overlay map");
constexpr int CW_TMO = 0;
constexpr int CW_BAR = 4096;
constexpr int CW_VSUM = 16384, CW_VSQ = CW_VSUM + M, CW_RSS2 = CW_VSQ + M, CW_RSS3 = CW_RSS2 + M;
static_assert((CW_RSS3 + M) * 4 <= (int)CTL_ZERO_BYTES, "CTL words inside the memset region");

constexpr int LDS_BYTES = 155648;
constexpr int MISC_OFF = 154624;

#define LAS __attribute__((address_space(3)))
typedef unsigned short bf16;
typedef float f32x4 __attribute__((ext_vector_type(4)));
typedef unsigned u32x4 __attribute__((ext_vector_type(4)));
typedef unsigned u32x2 __attribute__((ext_vector_type(2)));
typedef short bf16x8 __attribute__((ext_vector_type(8)));
#define LDS_WAIT() asm volatile("s_waitcnt lgkmcnt(0)" ::: "memory")
#define VM_WAIT() asm volatile("s_waitcnt vmcnt(0)" ::: "memory")
using pg8::cvt_pk_bf16; using pg8::bf_lo; using pg8::bf_hi; using pg8::sigmoid_f; using pg8::gelu_tanh_f;

#define XB_TMO      128
#define XB_XCNT(j)  (256  + 64 * (j))
#define XB_XSUB(j)  (1280 + 64 * (j))
#define XB_XGEN(j)  (2304 + 64 * (j))
#define XB_TOP      3328
#define XB_TOPGEN   3392
#define XCD_BAR_WORDS 3456
#define XB_SPIN_CAP (1u << 18)
__device__ __forceinline__ unsigned xb_ld(unsigned* p)              { return __hip_atomic_load(p, __ATOMIC_RELAXED, __HIP_MEMORY_SCOPE_AGENT); }
__device__ __forceinline__ unsigned xb_add(unsigned* p, unsigned v) { return __hip_atomic_fetch_add(p, v, __ATOMIC_RELAXED, __HIP_MEMORY_SCOPE_AGENT); }
__device__ __forceinline__ unsigned xb_xcc_id() { return (unsigned)__builtin_amdgcn_s_getreg((3 << 11) | 20) & 0xFu; }
#define XB_SPIN(cond, bar) do { unsigned _sp = 0; while (cond) { __builtin_amdgcn_s_sleep(1); \
    if ((++_sp & 255u) == 0u) { if (xb_ld(&(bar)[XB_TMO])) break; if (_sp > XB_SPIN_CAP) { atomicAdd(&(bar)[XB_TMO], 1u); break; } } } } while (0)
struct XcdBarrier { unsigned* bar; unsigned x; volatile LAS unsigned* st; };
__device__ __forceinline__ XcdBarrier xcd_barrier_post(unsigned* bar, volatile LAS unsigned* st) {
    XcdBarrier b; b.bar = bar; b.x = xb_xcc_id(); b.st = st;
    if (threadIdx.x == 0) (void)xb_add(&bar[XB_XCNT(b.x)], 1u);
    return b;
}
__device__ __forceinline__ void xcd_barrier_complete(unsigned* bar, unsigned x, unsigned& nloc, unsigned& nx) {
    const unsigned G = gridDim.x * gridDim.y * gridDim.z;
    unsigned sum, cnt, mine, sp = 0u;
    for (;;) {
        sum = 0u; cnt = 0u; mine = 0u;
#pragma unroll
        for (unsigned j = 0; j < 16; ++j) { const unsigned c = xb_ld(&bar[XB_XCNT(j)]); sum += c; cnt += (c > 0u) ? 1u : 0u; mine = (j == x) ? c : mine; }
        if (sum == G) break;
        __builtin_amdgcn_s_sleep(1);
        if ((++sp & 255u) == 0u) { if (xb_ld(&bar[XB_TMO])) break; if (sp > XB_SPIN_CAP) { atomicAdd(&bar[XB_TMO], 1u); break; } }
    }
    nloc = mine > 0u ? mine : 1u; nx = cnt > 0u ? cnt : 1u;
}
__device__ __forceinline__ void xcd_barrier(const XcdBarrier& b) {
    asm volatile("s_waitcnt vmcnt(0)" ::: "memory");
    __syncthreads();
    if (threadIdx.x == 0) {
        unsigned* bar = b.bar;
        __builtin_amdgcn_s_waitcnt(0);
        unsigned nloc = b.st[0], nx = b.st[1];
        if (nloc == 0u) { xcd_barrier_complete(bar, b.x, nloc, nx); b.st[0] = nloc; b.st[1] = nx; }
        const unsigned old = xb_add(&bar[XB_XSUB(b.x)], 1u);
        const unsigned gen = old / nloc;
        if (old + 1u == (gen + 1u) * nloc) {
            __builtin_amdgcn_fence(__ATOMIC_RELEASE, "agent");
            asm volatile("s_waitcnt vmcnt(0)" ::: "memory");
            const unsigned og = xb_add(&bar[XB_TOP], 1u);
            const unsigned tg = og / nx;
            if (og + 1u == (tg + 1u) * nx) xb_add(&bar[XB_TOPGEN], 1u);
            else XB_SPIN(xb_ld(&bar[XB_TOPGEN]) == tg, bar);
            __builtin_amdgcn_fence(__ATOMIC_ACQUIRE, "agent");
            xb_add(&bar[XB_XGEN(b.x)], 1u);
            asm volatile("s_waitcnt vmcnt(0)" ::: "memory");
        } else {
            XB_SPIN(xb_ld(&bar[XB_XGEN(b.x)]) == gen, bar);
            __builtin_amdgcn_fence(__ATOMIC_ACQUIRE, "agent");
            asm volatile("s_waitcnt vmcnt(0)" ::: "memory");
        }
    }
    __syncthreads();
}

__device__ __forceinline__ int opaque_tid() { int t = threadIdx.x; asm volatile("" : "+v"(t)); return t; }
__device__ __forceinline__ float wave_sum(float v) {
#pragma unroll
    for (int o = 1; o < 64; o <<= 1) v += __shfl_xor(v, o);
    return v;
}
__device__ __forceinline__ void tr_tile(const float* __restrict__ W, int ldw, bf16* __restrict__ WT, int ldt, int k0, int n0, LAS unsigned* scr, int lane) {
    const int nl = (lane & 15) * 4, kq = lane >> 4;
    f32x4 v[16];
#pragma unroll
    for (int i = 0; i < 8; ++i)
#pragma unroll
        for (int h = 0; h < 2; ++h) v[2 * i + h] = *(const f32x4*)(W + (size_t)(k0 + 8 * i + 2 * kq + h) * ldw + n0 + nl);
#pragma unroll
    for (int i = 0; i < 8; ++i)
#pragma unroll
        for (int j = 0; j < 4; ++j) scr[(nl + j) * 33 + 4 * i + kq] = cvt_pk_bf16(v[2 * i][j], v[2 * i + 1][j]);
    LDS_WAIT(); asm volatile("" ::: "memory");
    const int c = lane & 7, nr = lane >> 3;
#pragma unroll
    for (int it = 0; it < 8; ++it) { const int n = 8 * it + nr; const LAS unsigned* s = scr + n * 33 + 4 * c;
        u32x4 o; o.x = s[0]; o.y = s[1]; o.z = s[2]; o.w = s[3];
        *(u32x4*)(WT + (size_t)(n0 + n) * ldt + k0 + 8 * c) = o; }
    LDS_WAIT(); asm volatile("" ::: "memory");
}

struct Args { const float* in[23]; float* out; unsigned char* ws; int ph_lo, ph_hi; };

__device__ __forceinline__ void p0_prologue(const Args& a, LAS unsigned char* lds, int vcu, int G) {
    const int tid = opaque_tid(), lane = tid & 63, wave = __builtin_amdgcn_readfirstlane(tid >> 6);
    unsigned char* ws = a.ws;
    LAS unsigned* scr = (LAS unsigned*)(lds + wave * 8448);
    const int gw = vcu * NWAVES + wave, NGW = G * NWAVES;
    constexpr int T_IN = (DM / 64) * (INC / 64), T_UP = (DM / 64) * (UPN / 64), T_DN = (FFW / 64) * (DM / 64), T_PA = (SGW / 64) * (DM / 64), T_PB = (LW / 64) * (DM / 64), T_WO = (DM / 64) * (DM / 64), T_G = LH * 16;
    constexpr int NT = T_IN + T_UP + T_DN + T_PA + T_PB + T_WO + 2 * T_G;
    for (int it = gw; it < NT; it += NGW) {
        int r = it;
        if (r < T_IN) { const int nb = INC / 64; tr_tile(a.in[2], INC, (bf16*)(ws + WS_WIN), DM, 64 * (r / nb), 64 * (r % nb), scr, lane); continue; } r -= T_IN;
        if (r < T_UP) { const int nb = UPN / 64; tr_tile(a.in[18], UPN, (bf16*)(ws + WS_WUP), DM, 64 * (r / nb), 64 * (r % nb), scr, lane); continue; } r -= T_UP;
        if (r < T_DN) { const int nb = DM / 64; tr_tile(a.in[21], DM, (bf16*)(ws + WS_WDN), FFW, 64 * (r / nb), 64 * (r % nb), scr, lane); continue; } r -= T_DN;
        if (r < T_PA) { const int nb = DM / 64; tr_tile(a.in[14], DM, (bf16*)(ws + WS_PA), SGW, 64 * (r / nb), 64 * (r % nb), scr, lane); continue; } r -= T_PA;
        if (r < T_PB) { const int nb = DM / 64; tr_tile(a.in[15], DM, (bf16*)(ws + WS_PB), LW, 64 * (r / nb), 64 * (r % nb), scr, lane); continue; } r -= T_PB;
        if (r < T_WO) { const int nb = DM / 64; tr_tile(a.in[16], DM, (bf16*)(ws + WS_WOUT), DM, 64 * (r / nb), 64 * (r % nb), scr, lane); continue; } r -= T_WO;
        if (r < T_G) { const int hd = r >> 4, t = r & 15; tr_tile(a.in[9] + (size_t)hd * LHD * LHD, LHD, (bf16*)(ws + WS_WA) + (size_t)hd * LHD * LHD, LHD, 64 * (t >> 2), 64 * (t & 3), scr, lane); continue; } r -= T_G;
        { const int hd = r >> 4, t = r & 15; tr_tile(a.in[11] + (size_t)hd * LHD * LHD, LHD, (bf16*)(ws + WS_WX) + (size_t)hd * LHD * LHD, LHD, 64 * (t >> 2), 64 * (t & 3), scr, lane); }
    }
    const float* x = a.in[0]; const f32x4* gm = (const f32x4*)a.in[1] + lane; bf16* H = (bf16*)(ws + WS_H);
    for (int m = gw; m < M; m += NGW) {
        const f32x4* xr = (const f32x4*)(x + (size_t)m * DM) + lane; f32x4 v[16]; float s = 0.f;
#pragma unroll
        for (int j = 0; j < 16; ++j) { v[j] = xr[64 * j]; s += (v[j][0] * v[j][0] + v[j][1] * v[j][1]) + (v[j][2] * v[j][2] + v[j][3] * v[j][3]); }
        const float rs = 1.0f / sqrtf(wave_sum(s) * (1.0f / DM) + EPS);
        u32x2* o = (u32x2*)(H + (size_t)m * DM) + lane;
#pragma unroll
        for (int j = 0; j < 16; ++j) { const f32x4 g = gm[64 * j]; u32x2 w; w.x = cvt_pk_bf16(v[j][0] * rs * g[0], v[j][1] * rs * g[1]); w.y = cvt_pk_bf16(v[j][2] * rs * g[2], v[j][3] * rs * g[3]); o[64 * j] = w; }
    }
}

constexpr int MA_PITCH = 272;
constexpr int MA_WT = 0, MA_VN = 128 * MA_PITCH;
__device__ __forceinline__ void mixer_a_unit(const Args& a, LAS unsigned char* lds, int unit) {
    const int tid = opaque_tid(), lane = tid & 63, wave = __builtin_amdgcn_readfirstlane(tid >> 6);
    unsigned char* ws = a.ws;
    const int g = unit & 7, bc = unit >> 3;
    const int R0 = bc * CHUNK, C0 = g * SGD;
    const bf16* GU = (const bf16*)(ws + WS_GU); const bf16* GV = (const bf16*)(ws + WS_GV); bf16* YA = (bf16*)(ws + WS_YA);
    const float* vsum = (const float*)(ws + WS_CTL) + CW_VSUM; const float* vsq = (const float*)(ws + WS_CTL) + CW_VSQ;
    { const int t = tid >> 2, sq = tid & 3; const float* src = a.in[5] + ((size_t)g * CHUNK + t) * CHUNK + 32 * sq;
#pragma unroll
      for (int i = 0; i < 4; ++i) { const f32x4 w0 = *(const f32x4*)(src + 8 * i), w1 = *(const f32x4*)(src + 8 * i + 4); const int s0 = 32 * sq + 8 * i;
          float e[8] = {w0[0], w0[1], w0[2], w0[3], w1[0], w1[1], w1[2], w1[3]};
#pragma unroll
          for (int j = 0; j < 8; ++j) e[j] = (s0 + j <= t) ? e[j] : 0.f;
          u32x4 o; o.x = cvt_pk_bf16(e[0], e[1]); o.y = cvt_pk_bf16(e[2], e[3]); o.z = cvt_pk_bf16(e[4], e[5]); o.w = cvt_pk_bf16(e[6], e[7]);
          *(LAS u32x4*)(lds + MA_WT + t * MA_PITCH + s0 * 2) = o; } }
    { const int s0 = 2 * lane; const int r0 = R0 + s0;
      const float mu0 = vsum[r0] * (1.0f / SGW), mu1 = vsum[r0 + 1] * (1.0f / SGW);
      const float rs0 = 1.0f / sqrtf(fmaxf(vsq[r0] * (1.0f / SGW) - mu0 * mu0, 0.f) + EPS), rs1 = 1.0f / sqrtf(fmaxf(vsq[r0 + 1] * (1.0f / SGW) - mu1 * mu1, 0.f) + EPS);
#pragma unroll
      for (int it = 0; it < 4; ++it) { const int cg = wave * 4 + it; const int col = C0 + 8 * cg;
          const u32x4 q0 = *(const u32x4*)(GV + (size_t)r0 * SGW + col), q1 = *(const u32x4*)(GV + (size_t)(r0 + 1) * SGW + col);
          const f32x4 lg0 = *(const f32x4*)(a.in[3] + col), lg1 = *(const f32x4*)(a.in[3] + col + 4), lb0 = *(const f32x4*)(a.in[4] + col), lb1 = *(const f32x4*)(a.in[4] + col + 4);
          const float x0[8] = {bf_lo(q0.x), bf_hi(q0.x), bf_lo(q0.y), bf_hi(q0.y), bf_lo(q0.z), bf_hi(q0.z), bf_lo(q0.w), bf_hi(q0.w)};
          const float x1[8] = {bf_lo(q1.x), bf_hi(q1.x), bf_lo(q1.y), bf_hi(q1.y), bf_lo(q1.z), bf_hi(q1.z), bf_lo(q1.w), bf_hi(q1.w)};
          const float lg[8] = {lg0[0], lg0[1], lg0[2], lg0[3], lg1[0], lg1[1], lg1[2], lg1[3]}, lb[8] = {lb0[0], lb0[1], lb0[2], lb0[3], lb1[0], lb1[1], lb1[2], lb1[3]};
#pragma unroll
          for (int j = 0; j < 8; ++j) { const float n0 = (x0[j] - mu0) * rs0 * lg[j] + lb[j], n1 = (x1[j] - mu1) * rs1 * lg[j] + lb[j];
              *(LAS unsigned*)(lds + MA_VN + (8 * cg + j) * MA_PITCH + 4 * lane) = cvt_pk_bf16(n0, n1); } } }
    LDS_WAIT(); __syncthreads();
    const int fr = lane & 15, fq = lane >> 4;
    f32x4 acc[8][2];
#pragma unroll
    for (int m = 0; m < 8; ++m) { acc[m][0] = (f32x4){0.f, 0.f, 0.f, 0.f}; acc[m][1] = (f32x4){0.f, 0.f, 0.f, 0.f}; }
#pragma unroll
    for (int ks = 0; ks < 4; ++ks) {
        bf16x8 vf[2];
#pragma unroll
        for (int n = 0; n < 2; ++n) vf[n] = *(const LAS bf16x8*)(lds + MA_VN + (32 * wave + 16 * n + fr) * MA_PITCH + (32 * ks + 8 * fq) * 2);
#pragma unroll
        for (int m = 0; m < 8; ++m) { if (32 * ks > 16 * m + 15) continue;
            const bf16x8 wf = *(const LAS bf16x8*)(lds + MA_WT + (16 * m + fr) * MA_PITCH + (32 * ks + 8 * fq) * 2);
#pragma unroll
            for (int n = 0; n < 2; ++n) acc[m][n] = __builtin_amdgcn_mfma_f32_16x16x32_bf16(vf[n], wf, acc[m][n], 0, 0, 0); }
    }
#pragma unroll
    for (int m = 0; m < 8; ++m) { const int t = 16 * m + fr; const float bs = a.in[6][g * CHUNK + t];
#pragma unroll
        for (int n = 0; n < 2; ++n) { const size_t off = (size_t)(R0 + t) * SGW + C0 + 32 * wave + 16 * n + 4 * fq; const u32x2 gu = *(const u32x2*)(GU + off);
            u32x2 o; o.x = cvt_pk_bf16(bf_lo(gu.x) * (acc[m][n][0] + bs), bf_hi(gu.x) * (acc[m][n][1] + bs)); o.y = cvt_pk_bf16(bf_lo(gu.y) * (acc[m][n][2] + bs), bf_hi(gu.y) * (acc[m][n][3] + bs));
            *(u32x2*)(YA + off) = o; } }
    __syncthreads();
}

constexpr int MB_XPITCH = 528;
constexpr int MB_XC = 0, MB_A = 128 * MB_XPITCH  , MB_G = MB_A + 128 * 65 * 4  , MB_SEG = MB_G + 128 * 65 * 4  , MB_CARRY = MB_SEG + 4096  , MB_CTAB = MB_CARRY + 256  ;
static_assert(MB_CTAB + 5 * 256 * 4 <= MISC_OFF, "mixer B LDS map");
__device__ __forceinline__ void mixer_b_unit(const Args& a, LAS unsigned char* lds, int unit) {
    const int tid = opaque_tid(), lane = tid & 63, wave = __builtin_amdgcn_readfirstlane(tid >> 6);
    unsigned char* ws = a.ws;
    const int q = unit & 3, hd = (unit >> 2) & 15, b = unit >> 6;
    const int HC = hd * LHD, OC = HC + 64 * q;
    const bf16* XR = (const bf16*)(ws + WS_XR); const bf16* GYR = (const bf16*)(ws + WS_GYR); bf16* YB = (bf16*)(ws + WS_YB);
    const bf16* WaT = (const bf16*)(ws + WS_WA) + (size_t)hd * LHD * LHD; const bf16* WxT = (const bf16*)(ws + WS_WX) + (size_t)hd * LHD * LHD;
    const int fr = lane & 15, fq = lane >> 4, cb = wave & 3, rh = wave >> 2;
    bf16x8 bfa[8], bfx[8];
#pragma unroll
    for (int ks = 0; ks < 8; ++ks) { const size_t o = (size_t)(64 * q + 16 * cb + fr) * LHD + 32 * ks + 8 * fq; bfa[ks] = *(const bf16x8*)(WaT + o); bfx[ks] = *(const bf16x8*)(WxT + o); }
    float ba[4], bx[4], sp[4];
#pragma unroll
    for (int e = 0; e < 4; ++e) { const int col = OC + 16 * cb + 4 * fq + e; ba[e] = a.in[10][col]; bx[e] = a.in[12][col]; sp[e] = log1pf(expf(-a.in[13][col])); }
    const int cg = tid & 31, rg = tid >> 5;
    LAS float* ctab = (LAS float*)(lds + MB_CTAB);
    for (int i = tid; i < 5 * LHD; i += NWAVES * 64) { const int k = i >> 8, c = i & 255; ctab[i] = (k < 4) ? a.in[7][(size_t)k * LW + HC + c] : a.in[8][HC + c]; }
    LAS float* abuf = (LAS float*)(lds + MB_A); LAS float* gbuf = (LAS float*)(lds + MB_G);
    LAS float* segP = (LAS float*)(lds + MB_SEG); LAS float* segH = segP + 512; LAS float* carry = (LAS float*)(lds + MB_CARRY);
    if (tid < 64) carry[tid] = 0.f;
    LDS_WAIT(); __syncthreads();
    for (int step = 0; step < SEQ / 128; ++step) {
        const int t0 = step * 128; const size_t rowbase = (size_t)b * SEQ + t0;
        { const int r0 = 8 * rg; u32x4 raw[11];
#pragma unroll
          for (int i = 0; i < 11; ++i) { const int tt = t0 + r0 - 3 + i; raw[i] = (tt >= 0) ? *(const u32x4*)(XR + ((size_t)b * SEQ + tt) * LW + HC + 8 * cg) : (u32x4){0u, 0u, 0u, 0u}; }
          f32x4 cw[5][2];
#pragma unroll
          for (int k = 0; k < 5; ++k) { cw[k][0] = *(const LAS f32x4*)(ctab + k * LHD + 8 * cg); cw[k][1] = *(const LAS f32x4*)(ctab + k * LHD + 8 * cg + 4); }
#pragma unroll
          for (int r = 0; r < 8; ++r) { float o[8];
#pragma unroll
              for (int j = 0; j < 8; ++j) o[j] = cw[4][j >> 2][j & 3];
#pragma unroll
              for (int k = 0; k < 4; ++k) { const u32x4 w = raw[r + k];
                  o[0] += cw[k][0][0] * bf_lo(w.x); o[1] += cw[k][0][1] * bf_hi(w.x); o[2] += cw[k][0][2] * bf_lo(w.y); o[3] += cw[k][0][3] * bf_hi(w.y);
                  o[4] += cw[k][1][0] * bf_lo(w.z); o[5] += cw[k][1][1] * bf_hi(w.z); o[6] += cw[k][1][2] * bf_lo(w.w); o[7] += cw[k][1][3] * bf_hi(w.w); }
              u32x4 p; p.x = cvt_pk_bf16(o[0], o[1]); p.y = cvt_pk_bf16(o[2], o[3]); p.z = cvt_pk_bf16(o[4], o[5]); p.w = cvt_pk_bf16(o[6], o[7]);
              *(LAS u32x4*)(lds + MB_XC + (r0 + r) * MB_XPITCH + 16 * cg) = p; } }
        LDS_WAIT(); __syncthreads();
        f32x4 ca[4], cx[4];
#pragma unroll
        for (int m = 0; m < 4; ++m) { ca[m] = (f32x4){0.f, 0.f, 0.f, 0.f}; cx[m] = (f32x4){0.f, 0.f, 0.f, 0.f}; }
#pragma unroll
        for (int ks = 0; ks < 8; ++ks)
#pragma unroll
            for (int m = 0; m < 4; ++m) { const bf16x8 af = *(const LAS bf16x8*)(lds + MB_XC + (64 * rh + 16 * m + fr) * MB_XPITCH + (32 * ks + 8 * fq) * 2);
                ca[m] = __builtin_amdgcn_mfma_f32_16x16x32_bf16(bfa[ks], af, ca[m], 0, 0, 0); cx[m] = __builtin_amdgcn_mfma_f32_16x16x32_bf16(bfx[ks], af, cx[m], 0, 0, 0); }
#pragma unroll
        for (int m = 0; m < 4; ++m) { const int r = 64 * rh + 16 * m + fr; const int cl = 16 * cb + 4 * fq;
            const u32x2 xw = *(const LAS u32x2*)(lds + MB_XC + r * MB_XPITCH + (64 * q + cl) * 2);
            const float xv[4] = {bf_lo(xw.x), bf_hi(xw.x), bf_lo(xw.y), bf_hi(xw.y)};
#pragma unroll
            for (int e = 0; e < 4; ++e) { const float rg_ = sigmoid_f(ca[m][e] + ba[e]), ig = sigmoid_f(cx[m][e] + bx[e]);
                const float la = -8.0f * rg_ * sp[e]; const float av = __builtin_amdgcn_exp2f(1.4426950409f * la);
                const float y = 2.0f * la;
                const float ser = -y * (1.0f + y * (0.5f + y * (0.16666667f + y * (0.041666668f + y * (0.0083333338f + y * 0.0013888889f)))));
                const float om = (y > -0.25f) ? ser : (1.0f - av * av);
                abuf[r * 65 + cl + e] = av; gbuf[r * 65 + cl + e] = sqrtf(om) * ig * xv[e]; } }
        LDS_WAIT(); __syncthreads();
        { const int col = lane, sg = wave; float P = 1.f, Hh = 0.f; float av[16], gv[16];
#pragma unroll
          for (int i = 0; i < 16; ++i) { av[i] = abuf[(16 * sg + i) * 65 + col]; gv[i] = gbuf[(16 * sg + i) * 65 + col]; }
#pragma unroll
          for (int i = 0; i < 16; ++i) { Hh = av[i] * Hh + gv[i]; P *= av[i]; }
          segP[sg * 64 + col] = P; segH[sg * 64 + col] = Hh;
          LDS_WAIT(); __syncthreads();
          float c = carry[col];
          for (int s = 0; s < sg; ++s) c = segP[s * 64 + col] * c + segH[s * 64 + col];
          const size_t gb = (rowbase + 16 * sg) * LW + OC + col;
          unsigned short yr[16];
#pragma unroll
          for (int i = 0; i < 16; ++i) yr[i] = GYR[gb + (size_t)i * LW];
#pragma unroll
          for (int i = 0; i < 16; ++i) { c = av[i] * c + gv[i]; const float y = c * __uint_as_float((unsigned)yr[i] << 16); YB[gb + (size_t)i * LW] = (bf16)(cvt_pk_bf16(y, 0.f) & 0xffffu); }
          __syncthreads();
          if (sg == 7) carry[col] = c;
        }
        LDS_WAIT(); __syncthreads();
    }
}

__device__ __forceinline__ void p6_convgate(const Args& a, int vcu, int G) {
    const int gt = vcu * (NWAVES * 64) + opaque_tid(), NT = G * NWAVES * 64;
    unsigned char* ws = a.ws; const bf16* UP = (const bf16*)(ws + WS_UP); bf16* Gb = (bf16*)(ws + WS_G);
    constexpr int NCG = FFW / 8, RB = 32, NITEM = NCG * (M / RB);
    const float* cw = a.in[19]; const float* cbv = a.in[20];
    for (int item = gt; item < NITEM; item += NT) {
        const int cg = item % NCG, rb = item / NCG; const int c0 = 8 * cg, row0 = rb * RB; const bool first = (row0 % SEQ) == 0;
        float wg[3][8], wv[3][8], bg[8], bv[8];
#pragma unroll
        for (int k = 0; k < 3; ++k) { const f32x4 g0 = *(const f32x4*)(cw + (size_t)k * UPN + c0), g1 = *(const f32x4*)(cw + (size_t)k * UPN + c0 + 4), v0 = *(const f32x4*)(cw + (size_t)k * UPN + FFW + c0), v1 = *(const f32x4*)(cw + (size_t)k * UPN + FFW + c0 + 4);
#pragma unroll
            for (int j = 0; j < 4; ++j) { wg[k][j] = g0[j]; wg[k][4 + j] = g1[j]; wv[k][j] = v0[j]; wv[k][4 + j] = v1[j]; } }
        { const f32x4 g0 = *(const f32x4*)(cbv + c0), g1 = *(const f32x4*)(cbv + c0 + 4), v0 = *(const f32x4*)(cbv + FFW + c0), v1 = *(const f32x4*)(cbv + FFW + c0 + 4);
#pragma unroll
          for (int j = 0; j < 4; ++j) { bg[j] = g0[j]; bg[4 + j] = g1[j]; bv[j] = v0[j]; bv[4 + j] = v1[j]; } }
        u32x4 g2 = {0u, 0u, 0u, 0u}, g1 = g2, v2 = g2, v1 = g2;
        if (!first) { g2 = *(const u32x4*)(UP + (size_t)(row0 - 2) * UPN + c0); g1 = *(const u32x4*)(UP + (size_t)(row0 - 1) * UPN + c0);
                      v2 = *(const u32x4*)(UP + (size_t)(row0 - 2) * UPN + FFW + c0); v1 = *(const u32x4*)(UP + (size_t)(row0 - 1) * UPN + FFW + c0); }
#pragma unroll 4
        for (int r = 0; r < RB; ++r) { const u32x4 g0 = *(const u32x4*)(UP + (size_t)(row0 + r) * UPN + c0), v0 = *(const u32x4*)(UP + (size_t)(row0 + r) * UPN + FFW + c0);
            const unsigned gw2[4] = {g2.x, g2.y, g2.z, g2.w}, gw1[4] = {g1.x, g1.y, g1.z, g1.w}, gw0[4] = {g0.x, g0.y, g0.z, g0.w}, vw2[4] = {v2.x, v2.y, v2.z, v2.w}, vw1[4] = {v1.x, v1.y, v1.z, v1.w}, vw0[4] = {v0.x, v0.y, v0.z, v0.w};
            float o[8];
#pragma unroll
            for (int p = 0; p < 4; ++p) {
                const float cgl = bg[2 * p] + wg[0][2 * p] * bf_lo(gw2[p]) + wg[1][2 * p] * bf_lo(gw1[p]) + wg[2][2 * p] * bf_lo(gw0[p]);
                const float cgh = bg[2 * p + 1] + wg[0][2 * p + 1] * bf_hi(gw2[p]) + wg[1][2 * p + 1] * bf_hi(gw1[p]) + wg[2][2 * p + 1] * bf_hi(gw0[p]);
                const float cvl = bv[2 * p] + wv[0][2 * p] * bf_lo(vw2[p]) + wv[1][2 * p] * bf_lo(vw1[p]) + wv[2][2 * p] * bf_lo(vw0[p]);
                const float cvh = bv[2 * p + 1] + wv[0][2 * p + 1] * bf_hi(vw2[p]) + wv[1][2 * p + 1] * bf_hi(vw1[p]) + wv[2][2 * p + 1] * bf_hi(vw0[p]);
                o[2 * p] = gelu_tanh_f(cgl) * cvl; o[2 * p + 1] = gelu_tanh_f(cgh) * cvh; }
            u32x4 w; w.x = cvt_pk_bf16(o[0], o[1]); w.y = cvt_pk_bf16(o[2], o[3]); w.z = cvt_pk_bf16(o[4], o[5]); w.w = cvt_pk_bf16(o[6], o[7]);
            *(u32x4*)(Gb + (size_t)(row0 + r) * FFW + c0) = w;
            g2 = g1; g1 = g0; v2 = v1; v1 = v0; }
    }
}

__device__ __forceinline__ void p8_final(const Args& a, int vcu, int G) {
    const int tid = opaque_tid(), lane = tid & 63, gw = vcu * NWAVES + __builtin_amdgcn_readfirstlane(tid >> 6), NGW = G * NWAVES;
    const float* rss = (const float*)(a.ws + WS_CTL) + CW_RSS3; const f32x4* gf = (const f32x4*)a.in[22] + lane;
    for (int m = gw; m < M; m += NGW) { const float rs = 1.0f / sqrtf(rss[m] * (1.0f / DM) + EPS); f32x4* o = (f32x4*)(a.out + (size_t)m * DM) + lane;
#pragma unroll
        for (int j = 0; j < 16; ++j) { const f32x4 v = o[64 * j], g = gf[64 * j]; o[64 * j] = v * rs * g; } }
}

__global__ void __launch_bounds__(NWAVES * 64, 2) hyb_fwd(Args args) {
    extern __shared__ __attribute__((aligned(16))) unsigned char lds_raw[];
    LAS unsigned char* lds = (LAS unsigned char*)lds_raw;
    volatile LAS unsigned* MISC = (volatile LAS unsigned*)(lds + MISC_OFF);
    const int tid = threadIdx.x;
    const int G = gridDim.x; const int bx = blockIdx.x; const int vcu = (G % 8 == 0) ? (bx % 8) * (G / 8) + bx / 8 : bx;
    unsigned char* ws = args.ws;
    unsigned* ctl = (unsigned*)(ws + WS_CTL);
    for (int u = tid; u < (LDS_BYTES - MISC_OFF) / 4; u += NWAVES * 64) ((LAS unsigned*)(lds + MISC_OFF))[u] = 0u;
    __syncthreads();
    XcdBarrier bar; bar.bar = ctl + CW_BAR; bar.x = 0; bar.st = nullptr;
    if (N_LAUNCHES == 1) bar = xcd_barrier_post(ctl + CW_BAR, MISC + 8);
#define GRID_BAR() do { if (N_LAUNCHES == 1) xcd_barrier(bar); } while (0)
    const int lo = args.ph_lo, hi = args.ph_hi;
#ifndef PH_MASK
#define PH_MASK 0x1ff
#endif
#define IN(k) (((PH_MASK >> (k)) & 1) && lo <= (k) && (k) < hi)
#define BOTH(k) (IN(k) && IN((k) + 1))
    float* fctl = (float*)ctl;

    if (IN(0)) { p0_prologue(args, lds, vcu, G); if (BOTH(0)) GRID_BAR(); }

    if (IN(1)) {
        pg8::Gemm g{(const bf16*)(ws + WS_H), (const bf16*)(ws + WS_WIN), M, INC, DM}; pg8::StaticOrder S; S.init(M, INC, G, bx);
        pg8::EpiProj E{(bf16*)(ws + WS_GU), (bf16*)(ws + WS_GV), (bf16*)(ws + WS_XR), (bf16*)(ws + WS_GYR), (bf16*)(ws + WS_SGA), (bf16*)(ws + WS_SGB), fctl + CW_VSUM, fctl + CW_VSQ};
        pg8::gemm_phase<pg8::EpiProj, pg8::StaticOrder, PG8_ALIGN, PG8_SP2>(lds, g, S, E);
        if (BOTH(1)) GRID_BAR();
    }

    if (IN(2)) {
        for (int u = bx; u < NB * LH * 4; u += G) mixer_b_unit(args, lds, u);
        for (int u = bx; u < NB * (SEQ / CHUNK) * 8; u += G) mixer_a_unit(args, lds, u);
        if (BOTH(2)) GRID_BAR();
    }

    if (IN(3)) {
        { pg8::Gemm g{(const bf16*)(ws + WS_YA), (const bf16*)(ws + WS_PA), M, DM, SGW}; pg8::StaticOrder S; S.init(M, DM, G, bx);
          pg8::EpiPA E{(const bf16*)(ws + WS_SGA), (float*)(ws + WS_M1)};
          pg8::gemm_phase<pg8::EpiPA, pg8::StaticOrder, PG8_ALIGN, PG8_SP2>(lds, g, S, E); }
        { pg8::Gemm g{(const bf16*)(ws + WS_YB), (const bf16*)(ws + WS_PB), M, DM, LW}; pg8::StaticOrder S; S.init(M, DM, G, bx);
          pg8::EpiPB E{(const bf16*)(ws + WS_SGB), (const float*)(ws + WS_M1), (bf16*)(ws + WS_MRG)};
          pg8::gemm_phase<pg8::EpiPB, pg8::StaticOrder, PG8_ALIGN, PG8_SP2>(lds, g, S, E); }
        if (BOTH(3)) GRID_BAR();
    }

    if (IN(4)) {
        pg8::Gemm g{(const bf16*)(ws + WS_MRG), (const bf16*)(ws + WS_WOUT), M, DM, DM}; pg8::StaticOrder S; S.init(M, DM, G, bx);
        pg8::EpiResid<true> E{args.in[0], (float*)(ws + WS_X1), (bf16*)(ws + WS_X1B), args.in[17], fctl + CW_RSS2};
        pg8::gemm_phase<pg8::EpiResid<true>, pg8::StaticOrder, PG8_ALIGN, PG8_SP2>(lds, g, S, E);
        if (BOTH(4)) GRID_BAR();
    }

    if (IN(5)) {
        pg8::Gemm g{(const bf16*)(ws + WS_X1B), (const bf16*)(ws + WS_WUP), M, UPN, DM}; pg8::StaticOrder S; S.init(M, UPN, G, bx);
        pg8::EpiUp E{(bf16*)(ws + WS_UP), fctl + CW_RSS2};
        pg8::gemm_phase<pg8::EpiUp, pg8::StaticOrder, PG8_ALIGN, PG8_SP2>(lds, g, S, E);
        if (BOTH(5)) GRID_BAR();
    }

    if (IN(6)) { p6_convgate(args, vcu, G); if (BOTH(6)) GRID_BAR(); }

    if (IN(7)) {
        pg8::Gemm g{(const bf16*)(ws + WS_G), (const bf16*)(ws + WS_WDN), M, DM, FFW}; pg8::StaticOrder S; S.init(M, DM, G, bx);
        pg8::EpiResid<false> E{(const float*)(ws + WS_X1), args.out, nullptr, nullptr, fctl + CW_RSS3};
        pg8::gemm_phase<pg8::EpiResid<false>, pg8::StaticOrder, PG8_ALIGN, PG8_SP2>(lds, g, S, E);
        if (BOTH(7)) GRID_BAR();
    }

    if (IN(8)) p8_final(args, vcu, G);
#undef IN
#undef BOTH
#undef GRID_BAR
}

extern "C" void kernel_launch(void* const* d_in, const int* in_sizes, int n_in, void* d_out, int out_size, void* d_ws, size_t ws_size, hipStream_t stream) {
    static int grid = 0;
    if (grid == 0) {
        if (n_in != 23 || out_size != M * DM || ws_size < WS_END) { fprintf(stderr, "kernel_launch: unexpected shapes (n_in %d, out %d, ws %zu)\n", n_in, out_size, ws_size); grid = -1; return; }
        int dev = 0, cus = 0, per_cu = 0;
        if (hipGetDevice(&dev) != hipSuccess || hipDeviceGetAttribute(&cus, hipDeviceAttributeMultiprocessorCount, dev) != hipSuccess) { grid = -1; return; }
        if (hipFuncSetAttribute((const void*)hyb_fwd, hipFuncAttributeMaxDynamicSharedMemorySize, LDS_BYTES) != hipSuccess) { fprintf(stderr, "kernel_launch: hipFuncSetAttribute failed\n"); grid = -1; return; }
        if (hipOccupancyMaxActiveBlocksPerMultiprocessor(&per_cu, (const void*)hyb_fwd, NWAVES * 64, LDS_BYTES) != hipSuccess || per_cu < 1) { fprintf(stderr, "kernel_launch: occupancy query says %d\n", per_cu); }
        (void)hipGetLastError();
        grid = cus;
    }
    if (grid < 0) return;
    (void)in_sizes;
    (void)hipMemsetAsync((char*)d_ws + WS_CTL, 0, CTL_ZERO_BYTES, stream);
    Args a{};
    for (int i = 0; i < 23; ++i) a.in[i] = (const float*)d_in[i];
    a.out = (float*)d_out; a.ws = (unsigned char*)d_ws;
    if (N_LAUNCHES == 1) { a.ph_lo = 0; a.ph_hi = NPH; hipLaunchKernelGGL(hyb_fwd, dim3(grid), dim3(NWAVES * 64), LDS_BYTES, stream, a); }
    else for (int p = 0; p < NPH; ++p) { a.ph_lo = p; a.ph_hi = p + 1; hipLaunchKernelGGL(hyb_fwd, dim3(grid), dim3(NWAVES * 64), LDS_BYTES, stream, a); }
}
```

```cpp
#include <hip/hip_runtime.h>
#include <cstdio>
#include <cstdint>

#ifndef MK_N_LAUNCHES
#define MK_N_LAUNCHES 1
#endif

namespace pg8 {
#define PG8_LAS __attribute__((address_space(3)))
typedef unsigned short bf16_t;
typedef short bf16x8 __attribute__((ext_vector_type(8)));
typedef float f32x4 __attribute__((ext_vector_type(4)));
typedef unsigned u32x4 __attribute__((ext_vector_type(4)));
typedef unsigned u32x2 __attribute__((ext_vector_type(2)));
constexpr int BM = 256, BK = 64, HALF = 128, HTB = HALF * BK * 2  , STAGE_BYTES = 8 * HTB, NXCD = 8, WGM = 8;

__host__ __device__ __forceinline__ int lds_byte(int r, int c) { const int st = (r >> 4) * 2 + (c >> 5), rr = r & 15, cc = c & 31, ob = rr * 64 + cc * 2; return st * 1024 + (ob ^ (((ob >> 9) & 1) << 5)); }
__host__ __device__ __forceinline__ void stage_rc(int b, int& R, int& C) { const int st = b / 1024, sb = b % 1024, swz = sb ^ (((sb >> 9) & 1) << 5); R = (st >> 1) * 16 + swz / 64; C = (st & 1) * 32 + (swz % 64) / 2; }
__host__ __device__ __forceinline__ int perm32(int rho) { const int n = rho >> 4, i = rho & 15; return 8 * (i >> 2) + 4 * n + (i & 3); }

struct Unit { int pm, pn; };
struct Gemm { const bf16_t* A; const bf16_t* Bt; int M, N, K; };

struct StaticOrder {
    int nM, nN, nwg, G, c;
    __host__ __device__ void init(int M, int N, int G_, int c_) { nM = M / BM; nN = N / BM; nwg = nM * nN; G = G_; c = c_; }
    __host__ __device__ bool next(int i, Unit& u) const {
        const long L = (long)i * G + c; if (L >= nwg) return false;
        int wgid = (int)L; { const int q = nwg / NXCD, r = nwg % NXCD, xcd = wgid % NXCD, off = wgid / NXCD; wgid = (xcd < r ? xcd * (q + 1) : r * (q + 1) + (xcd - r) * q) + off; }
        const int nig = WGM * nN, gid = wgid / nig, fm = gid * WGM, gsz = (nM - fm) < WGM ? (nM - fm) : WGM;
        u.pm = fm + ((wgid % nig) % gsz); u.pn = (wgid % nig) / gsz; return true;
    }
    __device__ __forceinline__ void a_ready(const Unit&) const {}
    __device__ __forceinline__ void done(const Unit&) const {}
};

__device__ __forceinline__ unsigned cvt_pk_bf16(float lo, float hi) { unsigned r; asm volatile("v_cvt_pk_bf16_f32 %0, %1, %2" : "=v"(r) : "v"(lo), "v"(hi)); return r; }
__device__ __forceinline__ float bf_lo(unsigned w) { return __uint_as_float(w << 16); }
__device__ __forceinline__ float bf_hi(unsigned w) { return __uint_as_float(w & 0xffff0000u); }
__device__ __forceinline__ float sigmoid_f(float z) { return __builtin_amdgcn_rcpf(1.0f + __builtin_amdgcn_exp2f(-1.4426950409f * z)); }
__device__ __forceinline__ float gelu_tanh_f(float v) { const float z = 1.5957691216f * (v + 0.044715f * v * v * v); return v * sigmoid_f(z); }


struct EpiProj {
    static constexpr bool PERM = true, AFTER_DRAIN = false;
    bf16_t *GU, *GV, *XR, *GYR, *SGA, *SGB; float *vsum, *vsq;
    __device__ __forceinline__ void operator()(const f32x4 (&acc)[2][2][4][2], const Unit& u, int wr, int wc, int fr, int fq) const {
        const int pn = u.pn; bf16_t* base; int ldc, colt, act;
        if (pn < 8)       { base = GU;  ldc = 2048; colt = pn * 256;        act = 1; }
        else if (pn < 16) { base = GV;  ldc = 2048; colt = (pn - 8) * 256;  act = 1; }
        else if (pn < 32) { base = XR;  ldc = 4096; colt = (pn - 16) * 256; act = 0; }
        else if (pn < 48) { base = GYR; ldc = 4096; colt = (pn - 32) * 256; act = 1; }
        else if (pn < 64) { base = SGA; ldc = 4096; colt = (pn - 48) * 256; act = 2; }
        else              { base = SGB; ldc = 4096; colt = (pn - 64) * 256; act = 2; }
        const bool st = (pn >= 8) && (pn < 16);
        const int row0 = u.pm * BM + wr * 64 + fr, col0 = colt + wc * 32 + 8 * fq;
#pragma unroll
        for (int ai = 0; ai < 2; ++ai)
#pragma unroll
            for (int m = 0; m < 4; ++m) { const int row = row0 + ai * HALF + m * 16; bf16_t* rowp = base + (size_t)row * ldc + col0; float s = 0.f, q = 0.f;
#pragma unroll
                for (int bj = 0; bj < 2; ++bj) { f32x4 v0 = acc[ai][bj][m][0], v1 = acc[ai][bj][m][1];
                    if (act == 1) {
#pragma unroll
                        for (int j = 0; j < 4; ++j) { v0[j] = gelu_tanh_f(v0[j]); v1[j] = gelu_tanh_f(v1[j]); } }
                    else if (act == 2) {
#pragma unroll
                        for (int j = 0; j < 4; ++j) { v0[j] = sigmoid_f(v0[j]); v1[j] = sigmoid_f(v1[j]); } }
                    if (st) {
#pragma unroll
                        for (int j = 0; j < 4; ++j) { s += v0[j] + v1[j]; q += v0[j] * v0[j] + v1[j] * v1[j]; } }
                    u32x4 w; w.x = cvt_pk_bf16(v0[0], v0[1]); w.y = cvt_pk_bf16(v0[2], v0[3]); w.z = cvt_pk_bf16(v1[0], v1[1]); w.w = cvt_pk_bf16(v1[2], v1[3]);
                    *(u32x4*)(rowp + bj * HALF) = w; }
                if (st) { s += __shfl_xor(s, 16); s += __shfl_xor(s, 32); q += __shfl_xor(q, 16); q += __shfl_xor(q, 32);
                    if (fq == 0) { unsafeAtomicAdd(vsum + row, s); unsafeAtomicAdd(vsq + row, q); } } }
    }
};
struct EpiPA {
    static constexpr bool PERM = true, AFTER_DRAIN = false;
    const bf16_t* SG; float* M1;
    __device__ __forceinline__ void operator()(const f32x4 (&acc)[2][2][4][2], const Unit& u, int wr, int wc, int fr, int fq) const {
        const int row0 = u.pm * BM + wr * 64 + fr, col0 = u.pn * BM + wc * 32 + 8 * fq;
#pragma unroll
        for (int ai = 0; ai < 2; ++ai)
#pragma unroll
            for (int m = 0; m < 4; ++m) { const size_t off = (size_t)(row0 + ai * HALF + m * 16) * 4096 + col0;
#pragma unroll
                for (int bj = 0; bj < 2; ++bj) { const u32x4 g = *(const u32x4*)(SG + off + bj * HALF); const f32x4 a0 = acc[ai][bj][m][0], a1 = acc[ai][bj][m][1];
                    f32x4 o0, o1; o0[0] = a0[0] * bf_lo(g.x); o0[1] = a0[1] * bf_hi(g.x); o0[2] = a0[2] * bf_lo(g.y); o0[3] = a0[3] * bf_hi(g.y);
                    o1[0] = a1[0] * bf_lo(g.z); o1[1] = a1[1] * bf_hi(g.z); o1[2] = a1[2] * bf_lo(g.w); o1[3] = a1[3] * bf_hi(g.w);
                    *(f32x4*)(M1 + off + bj * HALF) = o0; *(f32x4*)(M1 + off + bj * HALF + 4) = o1; } }
    }
};
struct EpiPB {
    static constexpr bool PERM = true, AFTER_DRAIN = false;
    const bf16_t* SG; const float* M1; bf16_t* O;
    __device__ __forceinline__ void operator()(const f32x4 (&acc)[2][2][4][2], const Unit& u, int wr, int wc, int fr, int fq) const {
        const int row0 = u.pm * BM + wr * 64 + fr, col0 = u.pn * BM + wc * 32 + 8 * fq;
#pragma unroll
        for (int ai = 0; ai < 2; ++ai)
#pragma unroll
            for (int m = 0; m < 4; ++m) { const size_t off = (size_t)(row0 + ai * HALF + m * 16) * 4096 + col0;
#pragma unroll
                for (int bj = 0; bj < 2; ++bj) { const u32x4 g = *(const u32x4*)(SG + off + bj * HALF); const f32x4 a0 = acc[ai][bj][m][0], a1 = acc[ai][bj][m][1];
                    const f32x4 p0 = *(const f32x4*)(M1 + off + bj * HALF), p1 = *(const f32x4*)(M1 + off + bj * HALF + 4);
                    u32x4 w; w.x = cvt_pk_bf16(p0[0] + a0[0] * bf_lo(g.x), p0[1] + a0[1] * bf_hi(g.x)); w.y = cvt_pk_bf16(p0[2] + a0[2] * bf_lo(g.y), p0[3] + a0[3] * bf_hi(g.y));
                    w.z = cvt_pk_bf16(p1[0] + a1[0] * bf_lo(g.z), p1[1] + a1[1] * bf_hi(g.z)); w.w = cvt_pk_bf16(p1[2] + a1[2] * bf_lo(g.w), p1[3] + a1[3] * bf_hi(g.w));
                    *(u32x4*)(O + off + bj * HALF) = w; } }
    }
};
template <bool WITH_B> struct EpiResid {
    static constexpr bool PERM = true, AFTER_DRAIN = false;
    const float* XI; float* XO; bf16_t* XB; const float* gain; float* rowss;
    __device__ __forceinline__ void operator()(const f32x4 (&acc)[2][2][4][2], const Unit& u, int wr, int wc, int fr, int fq) const {
        const int row0 = u.pm * BM + wr * 64 + fr, col0 = u.pn * BM + wc * 32 + 8 * fq;
        f32x4 gv[2][2];
        if (WITH_B) {
#pragma unroll
            for (int bj = 0; bj < 2; ++bj) { gv[bj][0] = *(const f32x4*)(gain + col0 + bj * HALF); gv[bj][1] = *(const f32x4*)(gain + col0 + bj * HALF + 4); } }
#pragma unroll
        for (int ai = 0; ai < 2; ++ai)
#pragma unroll
            for (int m = 0; m < 4; ++m) { const int row = row0 + ai * HALF + m * 16; const size_t off = (size_t)row * 4096 + col0; float q = 0.f;
#pragma unroll
                for (int bj = 0; bj < 2; ++bj) { const f32x4 x0 = *(const f32x4*)(XI + off + bj * HALF) + acc[ai][bj][m][0], x1 = *(const f32x4*)(XI + off + bj * HALF + 4) + acc[ai][bj][m][1];
                    *(f32x4*)(XO + off + bj * HALF) = x0; *(f32x4*)(XO + off + bj * HALF + 4) = x1;
#pragma unroll
                    for (int j = 0; j < 4; ++j) q += x0[j] * x0[j] + x1[j] * x1[j];
                    if (WITH_B) { const f32x4 y0 = x0 * gv[bj][0], y1 = x1 * gv[bj][1]; u32x4 w; w.x = cvt_pk_bf16(y0[0], y0[1]); w.y = cvt_pk_bf16(y0[2], y0[3]); w.z = cvt_pk_bf16(y1[0], y1[1]); w.w = cvt_pk_bf16(y1[2], y1[3]);
                        *(u32x4*)(XB + off + bj * HALF) = w; } }
                q += __shfl_xor(q, 16); q += __shfl_xor(q, 32);
                if (fq == 0) unsafeAtomicAdd(rowss + row, q); }
    }
};
struct EpiUp {
    static constexpr bool PERM = true, AFTER_DRAIN = false;
    bf16_t* UP; const float* rowss;
    __device__ __forceinline__ void operator()(const f32x4 (&acc)[2][2][4][2], const Unit& u, int wr, int wc, int fr, int fq) const {
        const int row0 = u.pm * BM + wr * 64 + fr, col0 = u.pn * BM + wc * 32 + 8 * fq;
#pragma unroll
        for (int ai = 0; ai < 2; ++ai)
#pragma unroll
            for (int m = 0; m < 4; ++m) { const int row = row0 + ai * HALF + m * 16; const float rs = 1.0f / sqrtf(rowss[row] * (1.0f / 4096.0f) + 1e-6f); bf16_t* rowp = UP + (size_t)row * 24576 + col0;
#pragma unroll
                for (int bj = 0; bj < 2; ++bj) { const f32x4 v0 = acc[ai][bj][m][0] * rs, v1 = acc[ai][bj][m][1] * rs;
                    u32x4 w; w.x = cvt_pk_bf16(v0[0], v0[1]); w.y = cvt_pk_bf16(v0[2], v0[3]); w.z = cvt_pk_bf16(v1[0], v1[1]); w.w = cvt_pk_bf16(v1[2], v1[3]);
                    *(u32x4*)(rowp + bj * HALF) = w; } }
    }
};

template <class Epi, class Sched, bool ALIGN_EPI = false, bool SP2 = false>
__device__ __forceinline__ void gemm_phase(PG8_LAS unsigned char* lds, const Gemm g, const Sched& S, const Epi& E) {
    int tid = threadIdx.x; asm volatile("" : "+v"(tid));
    const int wid = __builtin_amdgcn_readfirstlane(tid >> 6), lane = tid & 63, wr = wid >> 2, wc = wid & 3, fr = lane & 15, fq = lane >> 4;
    const int K = g.K, nt = K / BK;
    unsigned voffA[2], voffB[2];
#pragma unroll
    for (int i = 0; i < 2; ++i) { int R, C; stage_rc(tid * 16 + i * 8192, R, C); const int Rb = Epi::PERM ? ((R & ~31) + perm32(R & 31)) : R;
        voffA[i] = (unsigned)(R * K + C) * 2u; voffB[i] = (unsigned)(Rb * K + C) * 2u; }
    const size_t kstep = (size_t)(BK * 2);
    const size_t hstep = (size_t)HALF * K * 2;
    const size_t tstep = 2 * hstep;
    const unsigned ldsw = (unsigned)wid * 1024u;
    const int aoff = lds_byte(wr * 64 + fr, fq * 8), boff = lds_byte(wc * 32 + fr, fq * 8);
#define PG8_SA(b, h) (((b) * 2 + (h)) * HTB)
#define PG8_SB(b, h) ((4 + (b) * 2 + (h)) * HTB)
#define PG8_STAGE(bufoff, gbase, voff) do { _Pragma("unroll") for (int _i = 0; _i < 2; ++_i) \
        __builtin_amdgcn_global_load_lds((const unsigned*)((const char*)(gbase) + (voff)[_i]), (PG8_LAS unsigned*)(lds + (bufoff) + ldsw + _i * 8192), 16, 0, 0); } while (0)
#define PG8_LDA(dst, b, h) do { _Pragma("unroll") for (int m = 0; m < 4; ++m) _Pragma("unroll") for (int k = 0; k < 2; ++k) dst[m][k] = *(const PG8_LAS bf16x8*)(lds + PG8_SA(b, h) + aoff + m * 2048 + k * 1024); } while (0)
#define PG8_LDB(dst, b, h) do { _Pragma("unroll") for (int n = 0; n < 2; ++n) _Pragma("unroll") for (int k = 0; k < 2; ++k) dst[n][k] = *(const PG8_LAS bf16x8*)(lds + PG8_SB(b, h) + boff + n * 2048 + k * 1024); } while (0)
#define PG8_MMA(ai, bj, At, Bt) do { __builtin_amdgcn_s_setprio(1); _Pragma("unroll") for (int m = 0; m < 4; ++m) _Pragma("unroll") for (int n = 0; n < 2; ++n) _Pragma("unroll") for (int k = 0; k < 2; ++k) \
        acc[ai][bj][m][n] = __builtin_amdgcn_mfma_f32_16x16x32_bf16(Bt[n][k], At[m][k], acc[ai][bj][m][n], 0, 0, 0); __builtin_amdgcn_s_setprio(0); } while (0)
#define PG8_WAIT_V(n) asm volatile("s_waitcnt vmcnt(" #n ")" ::: "memory")
#define PG8_WAIT_L(n) asm volatile("s_waitcnt lgkmcnt(" #n ")" ::: "memory")
#define PG8_BAR __builtin_amdgcn_s_barrier()
#define PG8_SCHED __builtin_amdgcn_sched_barrier(0)
    Unit cur, nxt; int ui = 0;
    if (!S.next(0, cur)) return;
    f32x4 acc[2][2][4][2];
#pragma unroll
    for (int a = 0; a < 2; ++a)
#pragma unroll
        for (int b = 0; b < 2; ++b)
#pragma unroll
            for (int m = 0; m < 4; ++m)
#pragma unroll
                for (int n = 0; n < 2; ++n) acc[a][b][m][n] = (f32x4){0.f, 0.f, 0.f, 0.f};
    bf16x8 At[4][2], B0[2][2], B1[2][2];
    const char* cA = (const char*)g.A + (size_t)cur.pm * tstep; const char* cB = (const char*)g.Bt + (size_t)cur.pn * tstep;
    S.a_ready(cur);
    if constexpr (SP2) {
        PG8_STAGE(PG8_SB(0, 0), cB, voffB); PG8_STAGE(PG8_SB(0, 1), cB + hstep, voffB); PG8_STAGE(PG8_SA(0, 0), cA, voffA); PG8_STAGE(PG8_SA(0, 1), cA + hstep, voffA);
        if (wr == 1) PG8_BAR;
        PG8_WAIT_V(2); PG8_BAR;
        PG8_STAGE(PG8_SB(1, 0), cB + kstep, voffB); PG8_STAGE(PG8_SA(1, 0), cA + kstep, voffA); PG8_STAGE(PG8_SB(1, 1), cB + hstep + kstep, voffB);
        PG8_WAIT_V(6); PG8_BAR;
    } else {
        PG8_STAGE(PG8_SB(0, 0), cB, voffB); PG8_STAGE(PG8_SA(0, 0), cA, voffA); PG8_STAGE(PG8_SB(0, 1), cB + hstep, voffB); PG8_STAGE(PG8_SA(0, 1), cA + hstep, voffA);
        if (wr == 1) PG8_BAR;
        PG8_WAIT_V(4); PG8_BAR;
        PG8_STAGE(PG8_SB(1, 0), cB + kstep, voffB); PG8_STAGE(PG8_SA(1, 0), cA + kstep, voffA); PG8_STAGE(PG8_SB(1, 1), cB + hstep + kstep, voffB);
        PG8_WAIT_V(6); PG8_BAR;
    }
    for (;;) {
        const bool has_next = S.next(ui + 1, nxt);
        const char* nA = has_next ? (const char*)g.A + (size_t)nxt.pm * tstep : cA; const char* nB = has_next ? (const char*)g.Bt + (size_t)nxt.pn * tstep : cB;
        for (int t = 0; t < nt; t += 2) {
            const bool last = (t == nt - 2);
            const char* a1 = cA + (size_t)(t + 1) * kstep;
            const char* a2 = last ? nA : cA + (size_t)(t + 2) * kstep; const char* b2 = last ? nB : cB + (size_t)(t + 2) * kstep;
            const char* a3 = a2 + kstep; const char* b3 = b2 + kstep;
            if (last && has_next) S.a_ready(nxt);
            if constexpr (SP2) {
            PG8_LDB(B0, 0, 0); PG8_LDB(B1, 0, 1); PG8_SCHED; PG8_LDA(At, 0, 0); PG8_STAGE(PG8_SA(1, 1), a1 + hstep, voffA);
            PG8_WAIT_V(8); PG8_WAIT_L(0); PG8_BAR; PG8_MMA(0, 0, At, B0); PG8_MMA(0, 1, At, B1); PG8_BAR; PG8_SCHED;
            PG8_LDA(At, 0, 1); PG8_STAGE(PG8_SB(0, 0), b2, voffB); PG8_STAGE(PG8_SB(0, 1), b2 + hstep, voffB); PG8_STAGE(PG8_SA(0, 0), a2, voffA);
            PG8_WAIT_V(8); PG8_WAIT_L(0); PG8_BAR; PG8_MMA(1, 0, At, B0); PG8_MMA(1, 1, At, B1); PG8_BAR; PG8_SCHED;
            PG8_LDB(B0, 1, 0); PG8_LDB(B1, 1, 1); PG8_SCHED; PG8_LDA(At, 1, 0); PG8_STAGE(PG8_SA(0, 1), a2 + hstep, voffA);
            PG8_WAIT_V(8); PG8_WAIT_L(0); PG8_BAR; PG8_MMA(0, 0, At, B0); PG8_MMA(0, 1, At, B1); PG8_BAR; PG8_SCHED;
            PG8_LDA(At, 1, 1); PG8_STAGE(PG8_SB(1, 0), b3, voffB); PG8_STAGE(PG8_SB(1, 1), b3 + hstep, voffB); PG8_STAGE(PG8_SA(1, 0), a3, voffA);
            PG8_WAIT_V(8); PG8_WAIT_L(0); PG8_BAR; PG8_MMA(1, 0, At, B0); PG8_MMA(1, 1, At, B1); PG8_BAR; PG8_SCHED;
            } else {
            PG8_LDB(B0, 0, 0); PG8_SCHED; PG8_LDA(At, 0, 0); PG8_STAGE(PG8_SA(1, 1), a1 + hstep, voffA);
            PG8_WAIT_L(8); PG8_BAR; PG8_WAIT_L(0); PG8_MMA(0, 0, At, B0); PG8_BAR; PG8_SCHED;
            PG8_LDB(B1, 0, 1); PG8_STAGE(PG8_SB(0, 0), b2, voffB);
            PG8_BAR; PG8_WAIT_L(0); PG8_MMA(0, 1, At, B1); PG8_BAR;
            PG8_LDA(At, 0, 1); PG8_STAGE(PG8_SA(0, 0), a2, voffA);
            PG8_BAR; PG8_WAIT_L(0); PG8_MMA(1, 0, At, B0); PG8_BAR; PG8_SCHED;
            PG8_STAGE(PG8_SB(0, 1), b2 + hstep, voffB);
            PG8_WAIT_V(6); PG8_BAR; PG8_MMA(1, 1, At, B1); PG8_BAR;
            PG8_LDB(B0, 1, 0); PG8_SCHED; PG8_LDA(At, 1, 0); PG8_STAGE(PG8_SA(0, 1), a2 + hstep, voffA);
            PG8_WAIT_L(8); PG8_BAR; PG8_WAIT_L(0); PG8_MMA(0, 0, At, B0); PG8_BAR; PG8_SCHED;
            PG8_LDB(B1, 1, 1); PG8_STAGE(PG8_SB(1, 0), b3, voffB);
            PG8_BAR; PG8_WAIT_L(0); PG8_MMA(0, 1, At, B1); PG8_BAR;
            PG8_LDA(At, 1, 1); PG8_STAGE(PG8_SA(1, 0), a3, voffA);
            PG8_BAR; PG8_WAIT_L(0); PG8_MMA(1, 0, At, B0); PG8_BAR; PG8_SCHED;
            PG8_STAGE(PG8_SB(1, 1), b3 + hstep, voffB);
            PG8_WAIT_V(6); PG8_BAR; PG8_MMA(1, 1, At, B1); PG8_BAR;
            }
        }
        if constexpr (ALIGN_EPI) { if (wr == 0) PG8_BAR; }
        E(acc, cur, wr, wc, fr, fq); S.done(cur);
        if (!has_next) break;
#pragma unroll
        for (int a = 0; a < 2; ++a)
#pragma unroll
            for (int b = 0; b < 2; ++b)
#pragma unroll
                for (int m = 0; m < 4; ++m)
#pragma unroll
                    for (int n = 0; n < 2; ++n) acc[a][b][m][n] = (f32x4){0.f, 0.f, 0.f, 0.f};
        cur = nxt; cA = nA; cB = nB; ++ui;
        if constexpr (ALIGN_EPI) { if (wr == 1) PG8_BAR; }
    }
    PG8_WAIT_V(0);
    if constexpr (!ALIGN_EPI) { if (wr == 0) PG8_BAR; }
    PG8_BAR;
#undef PG8_SA
#undef PG8_SB
#undef PG8_STAGE
#undef PG8_LDA
#undef PG8_LDB
#undef PG8_MMA
#undef PG8_WAIT_V
#undef PG8_WAIT_L
#undef PG8_BAR
#undef PG8_SCHED
}
}

#ifndef PG8_SP2
#define PG8_SP2 true
#endif
#ifndef PG8_ALIGN
#define PG8_ALIGN true
#endif

constexpr int NWAVES = 8;
constexpr int N_LAUNCHES = MK_N_LAUNCHES;
constexpr int NPH = 9;
constexpr int DM = 4096, SEQ = 2048, NB = 4, M = NB * SEQ;
constexpr int SGW = 2048, SGD = 256, CHUNK = 128;
constexpr int LW = 4096, LH = 16, LHD = 256;
constexpr int FFW = 12288, UPN = 2 * FFW, INC = 20480;
constexpr float EPS = 1e-6f;

constexpr size_t MiB = 1u << 20;
constexpr size_t WS_CTL = 0, CTL_ZERO_BYTES = 1 * MiB;
constexpr size_t WS_WIN = 2 * MiB, WS_WUP = 162 * MiB, WS_WDN = 354 * MiB, WS_PA = 450 * MiB, WS_PB = 466 * MiB, WS_WOUT = 498 * MiB, WS_WA = 530 * MiB, WS_WX = 532 * MiB;
constexpr size_t WS_H = 536 * MiB, WS_GU = 600 * MiB, WS_GV = 632 * MiB, WS_XR = 664 * MiB, WS_GYR = 728 * MiB, WS_SGA = 792 * MiB, WS_SGB = 856 * MiB;
constexpr size_t WS_YA = 920 * MiB, WS_YB = 952 * MiB, WS_M1 = 1016 * MiB, WS_MRG = 1144 * MiB, WS_X1 = 1208 * MiB, WS_X1B = 1336 * MiB, WS_END = 1400 * MiB;
constexpr size_t WS_UP = 536 * MiB;
constexpr size_t WS_G = 920 * MiB;
static_assert(WS_UP + (size_t)M * UPN * 2 <= WS_YA && WS_G + (size_t)M * FFW * 2 <= WS_MRG, "overlay map");
constexpr int CW_TMO = 0;
constexpr int CW_BAR = 4096;
constexpr int CW_VSUM = 16384, CW_VSQ = CW_VSUM + M, CW_RSS2 = CW_VSQ + M, CW_RSS3 = CW_RSS2 + M;
static_assert((CW_RSS3 + M) * 4 <= (int)CTL_ZERO_BYTES, "CTL words inside the memset region");

constexpr int LDS_BYTES = 155648;
constexpr int MISC_OFF = 154624;

#define LAS __attribute__((address_space(3)))
typedef unsigned short bf16;
typedef float f32x4 __attribute__((ext_vector_type(4)));
typedef unsigned u32x4 __attribute__((ext_vector_type(4)));
typedef unsigned u32x2 __attribute__((ext_vector_type(2)));
typedef short bf16x8 __attribute__((ext_vector_type(8)));
#define LDS_WAIT() asm volatile("s_waitcnt lgkmcnt(0)" ::: "memory")
#define VM_WAIT() asm volatile("s_waitcnt vmcnt(0)" ::: "memory")
using pg8::cvt_pk_bf16; using pg8::bf_lo; using pg8::bf_hi; using pg8::sigmoid_f; using pg8::gelu_tanh_f;

#define XB_TMO      128
#define XB_XCNT(j)  (256  + 64 * (j))
#define XB_XSUB(j)  (1280 + 64 * (j))
#define XB_XGEN(j)  (2304 + 64 * (j))
#define XB_TOP      3328
#define XB_TOPGEN   3392
#define XCD_BAR_WORDS 3456
#define XB_SPIN_CAP (1u << 18)
__device__ __forceinline__ unsigned xb_ld(unsigned* p)              { return __hip_atomic_load(p, __ATOMIC_RELAXED, __HIP_MEMORY_SCOPE_AGENT); }
__device__ __forceinline__ unsigned xb_add(unsigned* p, unsigned v) { return __hip_atomic_fetch_add(p, v, __ATOMIC_RELAXED, __HIP_MEMORY_SCOPE_AGENT); }
__device__ __forceinline__ unsigned xb_xcc_id() { return (unsigned)__builtin_amdgcn_s_getreg((3 << 11) | 20) & 0xFu; }
#define XB_SPIN(cond, bar) do { unsigned _sp = 0; while (cond) { __builtin_amdgcn_s_sleep(1); \
    if ((++_sp & 255u) == 0u) { if (xb_ld(&(bar)[XB_TMO])) break; if (_sp > XB_SPIN_CAP) { atomicAdd(&(bar)[XB_TMO], 1u); break; } } } } while (0)
struct XcdBarrier { unsigned* bar; unsigned x; volatile LAS unsigned* st; };
__device__ __forceinline__ XcdBarrier xcd_barrier_post(unsigned* bar, volatile LAS unsigned* st) {
    XcdBarrier b; b.bar = bar; b.x = xb_xcc_id(); b.st = st;
    if (threadIdx.x == 0) (void)xb_add(&bar[XB_XCNT(b.x)], 1u);
    return b;
}
__device__ __forceinline__ void xcd_barrier_complete(unsigned* bar, unsigned x, unsigned& nloc, unsigned& nx) {
    const unsigned G = gridDim.x * gridDim.y * gridDim.z;
    unsigned sum, cnt, mine, sp = 0u;
    for (;;) {
        sum = 0u; cnt = 0u; mine = 0u;
#pragma unroll
        for (unsigned j = 0; j < 16; ++j) { const unsigned c = xb_ld(&bar[XB_XCNT(j)]); sum += c; cnt += (c > 0u) ? 1u : 0u; mine = (j == x) ? c : mine; }
        if (sum == G) break;
        __builtin_amdgcn_s_sleep(1);
        if ((++sp & 255u) == 0u) { if (xb_ld(&bar[XB_TMO])) break; if (sp > XB_SPIN_CAP) { atomicAdd(&bar[XB_TMO], 1u); break; } }
    }
    nloc = mine > 0u ? mine : 1u; nx = cnt > 0u ? cnt : 1u;
}
__device__ __forceinline__ void xcd_barrier(const XcdBarrier& b) {
    asm volatile("s_waitcnt vmcnt(0)" ::: "memory");
    __syncthreads();
    if (threadIdx.x == 0) {
        unsigned* bar = b.bar;
        __builtin_amdgcn_s_waitcnt(0);
        unsigned nloc = b.st[0], nx = b.st[1];
        if (nloc == 0u) { xcd_barrier_complete(bar, b.x, nloc, nx); b.st[0] = nloc; b.st[1] = nx; }
        const unsigned old = xb_add(&bar[XB_XSUB(b.x)], 1u);
        const unsigned gen = old / nloc;
        if (old + 1u == (gen + 1u) * nloc) {
            __builtin_amdgcn_fence(__ATOMIC_RELEASE, "agent");
            asm volatile("s_waitcnt vmcnt(0)" ::: "memory");
            const unsigned og = xb_add(&bar[XB_TOP], 1u);
            const unsigned tg = og / nx;
            if (og + 1u == (tg + 1u) * nx) xb_add(&bar[XB_TOPGEN], 1u);
            else XB_SPIN(xb_ld(&bar[XB_TOPGEN]) == tg, bar);
            __builtin_amdgcn_fence(__ATOMIC_ACQUIRE, "agent");
            xb_add(&bar[XB_XGEN(b.x)], 1u);
            asm volatile("s_waitcnt vmcnt(0)" ::: "memory");
        } else {
            XB_SPIN(xb_ld(&bar[XB_XGEN(b.x)]) == gen, bar);
            __builtin_amdgcn_fence(__ATOMIC_ACQUIRE, "agent");
            asm volatile("s_waitcnt vmcnt(0)" ::: "memory");
        }
    }
    __syncthreads();
}

__device__ __forceinline__ int opaque_tid() { int t = threadIdx.x; asm volatile("" : "+v"(t)); return t; }
__device__ __forceinline__ float wave_sum(float v) {
#pragma unroll
    for (int o = 1; o < 64; o <<= 1) v += __shfl_xor(v, o);
    return v;
}
__device__ __forceinline__ void tr_tile(const float* __restrict__ W, int ldw, bf16* __restrict__ WT, int ldt, int k0, int n0, LAS unsigned* scr, int lane) {
    const int nl = (lane & 15) * 4, kq = lane >> 4;
    f32x4 v[16];
#pragma unroll
    for (int i = 0; i < 8; ++i)
#pragma unroll
        for (int h = 0; h < 2; ++h) v[2 * i + h] = *(const f32x4*)(W + (size_t)(k0 + 8 * i + 2 * kq + h) * ldw + n0 + nl);
#pragma unroll
    for (int i = 0; i < 8; ++i)
#pragma unroll
        for (int j = 0; j < 4; ++j) scr[(nl + j) * 33 + 4 * i + kq] = cvt_pk_bf16(v[2 * i][j], v[2 * i + 1][j]);
    LDS_WAIT(); asm volatile("" ::: "memory");
    const int c = lane & 7, nr = lane >> 3;
#pragma unroll
    for (int it = 0; it < 8; ++it) { const int n = 8 * it + nr; const LAS unsigned* s = scr + n * 33 + 4 * c;
        u32x4 o; o.x = s[0]; o.y = s[1]; o.z = s[2]; o.w = s[3];
        *(u32x4*)(WT + (size_t)(n0 + n) * ldt + k0 + 8 * c) = o; }
    LDS_WAIT(); asm volatile("" ::: "memory");
}

struct Args { const float* in[23]; float* out; unsigned char* ws; int ph_lo, ph_hi; };

__device__ __forceinline__ void p0_prologue(const Args& a, LAS unsigned char* lds, int vcu, int G) {
    const int tid = opaque_tid(), lane = tid & 63, wave = __builtin_amdgcn_readfirstlane(tid >> 6);
    unsigned char* ws = a.ws;
    LAS unsigned* scr = (LAS unsigned*)(lds + wave * 8448);
    const int gw = vcu * NWAVES + wave, NGW = G * NWAVES;
    constexpr int T_IN = (DM / 64) * (INC / 64), T_UP = (DM / 64) * (UPN / 64), T_DN = (FFW / 64) * (DM / 64), T_PA = (SGW / 64) * (DM / 64), T_PB = (LW / 64) * (DM / 64), T_WO = (DM / 64) * (DM / 64), T_G = LH * 16;
    constexpr int NT = T_IN + T_UP + T_DN + T_PA + T_PB + T_WO + 2 * T_G;
    for (int it = gw; it < NT; it += NGW) {
        int r = it;
        if (r < T_IN) { const int nb = INC / 64; tr_tile(a.in[2], INC, (bf16*)(ws + WS_WIN), DM, 64 * (r / nb), 64 * (r % nb), scr, lane); continue; } r -= T_IN;
        if (r < T_UP) { const int nb = UPN / 64; tr_tile(a.in[18], UPN, (bf16*)(ws + WS_WUP), DM, 64 * (r / nb), 64 * (r % nb), scr, lane); continue; } r -= T_UP;
        if (r < T_DN) { const int nb = DM / 64; tr_tile(a.in[21], DM, (bf16*)(ws + WS_WDN), FFW, 64 * (r / nb), 64 * (r % nb), scr, lane); continue; } r -= T_DN;
        if (r < T_PA) { const int nb = DM / 64; tr_tile(a.in[14], DM, (bf16*)(ws + WS_PA), SGW, 64 * (r / nb), 64 * (r % nb), scr, lane); continue; } r -= T_PA;
        if (r < T_PB) { const int nb = DM / 64; tr_tile(a.in[15], DM, (bf16*)(ws + WS_PB), LW, 64 * (r / nb), 64 * (r % nb), scr, lane); continue; } r -= T_PB;
        if (r < T_WO) { const int nb = DM / 64; tr_tile(a.in[16], DM, (bf16*)(ws + WS_WOUT), DM, 64 * (r / nb), 64 * (r % nb), scr, lane); continue; } r -= T_WO;
        if (r < T_G) { const int hd = r >> 4, t = r & 15; tr_tile(a.in[9] + (size_t)hd * LHD * LHD, LHD, (bf16*)(ws + WS_WA) + (size_t)hd * LHD * LHD, LHD, 64 * (t >> 2), 64 * (t & 3), scr, lane); continue; } r -= T_G;
        { const int hd = r >> 4, t = r & 15; tr_tile(a.in[11] + (size_t)hd * LHD * LHD, LHD, (bf16*)(ws + WS_WX) + (size_t)hd * LHD * LHD, LHD, 64 * (t >> 2), 64 * (t & 3), scr, lane); }
    }
    const float* x = a.in[0]; const f32x4* gm = (const f32x4*)a.in[1] + lane; bf16* H = (bf16*)(ws + WS_H);
    for (int m = gw; m < M; m += NGW) {
        const f32x4* xr = (const f32x4*)(x + (size_t)m * DM) + lane; f32x4 v[16]; float s = 0.f;
#pragma unroll
        for (int j = 0; j < 16; ++j) { v[j] = xr[64 * j]; s += (v[j][0] * v[j][0] + v[j][1] * v[j][1]) + (v[j][2] * v[j][2] + v[j][3] * v[j][3]); }
        const float rs = 1.0f / sqrtf(wave_sum(s) * (1.0f / DM) + EPS);
        u32x2* o = (u32x2*)(H + (size_t)m * DM) + lane;
#pragma unroll
        for (int j = 0; j < 16; ++j) { const f32x4 g = gm[64 * j]; u32x2 w; w.x = cvt_pk_bf16(v[j][0] * rs * g[0], v[j][1] * rs * g[1]); w.y = cvt_pk_bf16(v[j][2] * rs * g[2], v[j][3] * rs * g[3]); o[64 * j] = w; }
    }
}

constexpr int MA_PITCH = 272;
constexpr int MA_WT = 0, MA_VN = 128 * MA_PITCH;
__device__ __forceinline__ void mixer_a_unit(const Args& a, LAS unsigned char* lds, int unit) {
    const int tid = opaque_tid(), lane = tid & 63, wave = __builtin_amdgcn_readfirstlane(tid >> 6);
    unsigned char* ws = a.ws;
    const int g = unit & 7, bc = unit >> 3;
    const int R0 = bc * CHUNK, C0 = g * SGD;
    const bf16* GU = (const bf16*)(ws + WS_GU); const bf16* GV = (const bf16*)(ws + WS_GV); bf16* YA = (bf16*)(ws + WS_YA);
    const float* vsum = (const float*)(ws + WS_CTL) + CW_VSUM; const float* vsq = (const float*)(ws + WS_CTL) + CW_VSQ;
    { const int t = tid >> 2, sq = tid & 3; const float* src = a.in[5] + ((size_t)g * CHUNK + t) * CHUNK + 32 * sq;
#pragma unroll
      for (int i = 0; i < 4; ++i) { const f32x4 w0 = *(const f32x4*)(src + 8 * i), w1 = *(const f32x4*)(src + 8 * i + 4); const int s0 = 32 * sq + 8 * i;
          float e[8] = {w0[0], w0[1], w0[2], w0[3], w1[0], w1[1], w1[2], w1[3]};
#pragma unroll
          for (int j = 0; j < 8; ++j) e[j] = (s0 + j <= t) ? e[j] : 0.f;
          u32x4 o; o.x = cvt_pk_bf16(e[0], e[1]); o.y = cvt_pk_bf16(e[2], e[3]); o.z = cvt_pk_bf16(e[4], e[5]); o.w = cvt_pk_bf16(e[6], e[7]);
          *(LAS u32x4*)(lds + MA_WT + t * MA_PITCH + s0 * 2) = o; } }
    { const int s0 = 2 * lane; const int r0 = R0 + s0;
      const float mu0 = vsum[r0] * (1.0f / SGW), mu1 = vsum[r0 + 1] * (1.0f / SGW);
      const float rs0 = 1.0f / sqrtf(fmaxf(vsq[r0] * (1.0f / SGW) - mu0 * mu0, 0.f) + EPS), rs1 = 1.0f / sqrtf(fmaxf(vsq[r0 + 1] * (1.0f / SGW) - mu1 * mu1, 0.f) + EPS);
#pragma unroll
      for (int it = 0; it < 4; ++it) { const int cg = wave * 4 + it; const int col = C0 + 8 * cg;
          const u32x4 q0 = *(const u32x4*)(GV + (size_t)r0 * SGW + col), q1 = *(const u32x4*)(GV + (size_t)(r0 + 1) * SGW + col);
          const f32x4 lg0 = *(const f32x4*)(a.in[3] + col), lg1 = *(const f32x4*)(a.in[3] + col + 4), lb0 = *(const f32x4*)(a.in[4] + col), lb1 = *(const f32x4*)(a.in[4] + col + 4);
          const float x0[8] = {bf_lo(q0.x), bf_hi(q0.x), bf_lo(q0.y), bf_hi(q0.y), bf_lo(q0.z), bf_hi(q0.z), bf_lo(q0.w), bf_hi(q0.w)};
          const float x1[8] = {bf_lo(q1.x), bf_hi(q1.x), bf_lo(q1.y), bf_hi(q1.y), bf_lo(q1.z), bf_hi(q1.z), bf_lo(q1.w), bf_hi(q1.w)};
          const float lg[8] = {lg0[0], lg0[1], lg0[2], lg0[3], lg1[0], lg1[1], lg1[2], lg1[3]}, lb[8] = {lb0[0], lb0[1], lb0[2], lb0[3], lb1[0], lb1[1], lb1[2], lb1[3]};
#pragma unroll
          for (int j = 0; j < 8; ++j) { const float n0 = (x0[j] - mu0) * rs0 * lg[j] + lb[j], n1 = (x1[j] - mu1) * rs1 * lg[j] + lb[j];
              *(LAS unsigned*)(lds + MA_VN + (8 * cg + j) * MA_PITCH + 4 * lane) = cvt_pk_bf16(n0, n1); } } }
    LDS_WAIT(); __syncthreads();
    const int fr = lane & 15, fq = lane >> 4;
    f32x4 acc[8][2];
#pragma unroll
    for (int m = 0; m < 8; ++m) { acc[m][0] = (f32x4){0.f, 0.f, 0.f, 0.f}; acc[m][1] = (f32x4){0.f, 0.f, 0.f, 0.f}; }
#pragma unroll
    for (int ks = 0; ks < 4; ++ks) {
        bf16x8 vf[2];
#pragma unroll
        for (int n = 0; n < 2; ++n) vf[n] = *(const LAS bf16x8*)(lds + MA_VN + (32 * wave + 16 * n + fr) * MA_PITCH + (32 * ks + 8 * fq) * 2);
#pragma unroll
        for (int m = 0; m < 8; ++m) { if (32 * ks > 16 * m + 15) continue;
            const bf16x8 wf = *(const LAS bf16x8*)(lds + MA_WT + (16 * m + fr) * MA_PITCH + (32 * ks + 8 * fq) * 2);
#pragma unroll
            for (int n = 0; n < 2; ++n) acc[m][n] = __builtin_amdgcn_mfma_f32_16x16x32_bf16(vf[n], wf, acc[m][n], 0, 0, 0); }
    }
#pragma unroll
    for (int m = 0; m < 8; ++m) { const int t = 16 * m + fr; const float bs = a.in[6][g * CHUNK + t];
#pragma unroll
        for (int n = 0; n < 2; ++n) { const size_t off = (size_t)(R0 + t) * SGW + C0 + 32 * wave + 16 * n + 4 * fq; const u32x2 gu = *(const u32x2*)(GU + off);
            u32x2 o; o.x = cvt_pk_bf16(bf_lo(gu.x) * (acc[m][n][0] + bs), bf_hi(gu.x) * (acc[m][n][1] + bs)); o.y = cvt_pk_bf16(bf_lo(gu.y) * (acc[m][n][2] + bs), bf_hi(gu.y) * (acc[m][n][3] + bs));
            *(u32x2*)(YA + off) = o; } }
    __syncthreads();
}

constexpr int MB_XPITCH = 528;
constexpr int MB_XC = 0, MB_A = 128 * MB_XPITCH  , MB_G = MB_A + 128 * 65 * 4  , MB_SEG = MB_G + 128 * 65 * 4  , MB_CARRY = MB_SEG + 4096  , MB_CTAB = MB_CARRY + 256  ;
static_assert(MB_CTAB + 5 * 256 * 4 <= MISC_OFF, "mixer B LDS map");
__device__ __forceinline__ void mixer_b_unit(const Args& a, LAS unsigned char* lds, int unit) {
    const int tid = opaque_tid(), lane = tid & 63, wave = __builtin_amdgcn_readfirstlane(tid >> 6);
    unsigned char* ws = a.ws;
    const int q = unit & 3, hd = (unit >> 2) & 15, b = unit >> 6;
    const int HC = hd * LHD, OC = HC + 64 * q;
    const bf16* XR = (const bf16*)(ws + WS_XR); const bf16* GYR = (const bf16*)(ws + WS_GYR); bf16* YB = (bf16*)(ws + WS_YB);
    const bf16* WaT = (const bf16*)(ws + WS_WA) + (size_t)hd * LHD * LHD; const bf16* WxT = (const bf16*)(ws + WS_WX) + (size_t)hd * LHD * LHD;
    const int fr = lane & 15, fq = lane >> 4, cb = wave & 3, rh = wave >> 2;
    bf16x8 bfa[8], bfx[8];
#pragma unroll
    for (int ks = 0; ks < 8; ++ks) { const size_t o = (size_t)(64 * q + 16 * cb + fr) * LHD + 32 * ks + 8 * fq; bfa[ks] = *(const bf16x8*)(WaT + o); bfx[ks] = *(const bf16x8*)(WxT + o); }
    float ba[4], bx[4], sp[4];
#pragma unroll
    for (int e = 0; e < 4; ++e) { const int col = OC + 16 * cb + 4 * fq + e; ba[e] = a.in[10][col]; bx[e] = a.in[12][col]; sp[e] = log1pf(expf(-a.in[13][col])); }
    const int cg = tid & 31, rg = tid >> 5;
    LAS float* ctab = (LAS float*)(lds + MB_CTAB);
    for (int i = tid; i < 5 * LHD; i += NWAVES * 64) { const int k = i >> 8, c = i & 255; ctab[i] = (k < 4) ? a.in[7][(size_t)k * LW + HC + c] : a.in[8][HC + c]; }
    LAS float* abuf = (LAS float*)(lds + MB_A); LAS float* gbuf = (LAS float*)(lds + MB_G);
    LAS float* segP = (LAS float*)(lds + MB_SEG); LAS float* segH = segP + 512; LAS float* carry = (LAS float*)(lds + MB_CARRY);
    if (tid < 64) carry[tid] = 0.f;
    LDS_WAIT(); __syncthreads();
    for (int step = 0; step < SEQ / 128; ++step) {
        const int t0 = step * 128; const size_t rowbase = (size_t)b * SEQ + t0;
        { const int r0 = 8 * rg; u32x4 raw[11];
#pragma unroll
          for (int i = 0; i < 11; ++i) { const int tt = t0 + r0 - 3 + i; raw[i] = (tt >= 0) ? *(const u32x4*)(XR + ((size_t)b * SEQ + tt) * LW + HC + 8 * cg) : (u32x4){0u, 0u, 0u, 0u}; }
          f32x4 cw[5][2];
#pragma unroll
          for (int k = 0; k < 5; ++k) { cw[k][0] = *(const LAS f32x4*)(ctab + k * LHD + 8 * cg); cw[k][1] = *(const LAS f32x4*)(ctab + k * LHD + 8 * cg + 4); }
#pragma unroll
          for (int r = 0; r < 8; ++r) { float o[8];
#pragma unroll
              for (int j = 0; j < 8; ++j) o[j] = cw[4][j >> 2][j & 3];
#pragma unroll
              for (int k = 0; k < 4; ++k) { const u32x4 w = raw[r + k];
                  o[0] += cw[k][0][0] * bf_lo(w.x); o[1] += cw[k][0][1] * bf_hi(w.x); o[2] += cw[k][0][2] * bf_lo(w.y); o[3] += cw[k][0][3] * bf_hi(w.y);
                  o[4] += cw[k][1][0] * bf_lo(w.z); o[5] += cw[k][1][1] * bf_hi(w.z); o[6] += cw[k][1][2] * bf_lo(w.w); o[7] += cw[k][1][3] * bf_hi(w.w); }
              u32x4 p; p.x = cvt_pk_bf16(o[0], o[1]); p.y = cvt_pk_bf16(o[2], o[3]); p.z = cvt_pk_bf16(o[4], o[5]); p.w = cvt_pk_bf16(o[6], o[7]);
              *(LAS u32x4*)(lds + MB_XC + (r0 + r) * MB_XPITCH + 16 * cg) = p; } }
        LDS_WAIT(); __syncthreads();
        f32x4 ca[4], cx[4];
#pragma unroll
        for (int m = 0; m < 4; ++m) { ca[m] = (f32x4){0.f, 0.f, 0.f, 0.f}; cx[m] = (f32x4){0.f, 0.f, 0.f, 0.f}; }
#pragma unroll
        for (int ks = 0; ks < 8; ++ks)
#pragma unroll
            for (int m = 0; m < 4; ++m) { const bf16x8 af = *(const LAS bf16x8*)(lds + MB_XC + (64 * rh + 16 * m + fr) * MB_XPITCH + (32 * ks + 8 * fq) * 2);
                ca[m] = __builtin_amdgcn_mfma_f32_16x16x32_bf16(bfa[ks], af, ca[m], 0, 0, 0); cx[m] = __builtin_amdgcn_mfma_f32_16x16x32_bf16(bfx[ks], af, cx[m], 0, 0, 0); }
#pragma unroll
        for (int m = 0; m < 4; ++m) { const int r = 64 * rh + 16 * m + fr; const int cl = 16 * cb + 4 * fq;
            const u32x2 xw = *(const LAS u32x2*)(lds + MB_XC + r * MB_XPITCH + (64 * q + cl) * 2);
            const float xv[4] = {bf_lo(xw.x), bf_hi(xw.x), bf_lo(xw.y), bf_hi(xw.y)};
#pragma unroll
            for (int e = 0; e < 4; ++e) { const float rg_ = sigmoid_f(ca[m][e] + ba[e]), ig = sigmoid_f(cx[m][e] + bx[e]);
                const float la = -8.0f * rg_ * sp[e]; const float av = __builtin_amdgcn_exp2f(1.4426950409f * la);
                const float y = 2.0f * la;
                const float ser = -y * (1.0f + y * (0.5f + y * (0.16666667f + y * (0.041666668f + y * (0.0083333338f + y * 0.0013888889f)))));
                const float om = (y > -0.25f) ? ser : (1.0f - av * av);
                abuf[r * 65 + cl + e] = av; gbuf[r * 65 + cl + e] = sqrtf(om) * ig * xv[e]; } }
        LDS_WAIT(); __syncthreads();
        { const int col = lane, sg = wave; float P = 1.f, Hh = 0.f; float av[16], gv[16];
#pragma unroll
          for (int i = 0; i < 16; ++i) { av[i] = abuf[(16 * sg + i) * 65 + col]; gv[i] = gbuf[(16 * sg + i) * 65 + col]; }
#pragma unroll
          for (int i = 0; i < 16; ++i) { Hh = av[i] * Hh + gv[i]; P *= av[i]; }
          segP[sg * 64 + col] = P; segH[sg * 64 + col] = Hh;
          LDS_WAIT(); __syncthreads();
          float c = carry[col];
          for (int s = 0; s < sg; ++s) c = segP[s * 64 + col] * c + segH[s * 64 + col];
          const size_t gb = (rowbase + 16 * sg) * LW + OC + col;
          unsigned short yr[16];
#pragma unroll
          for (int i = 0; i < 16; ++i) yr[i] = GYR[gb + (size_t)i * LW];
#pragma unroll
          for (int i = 0; i < 16; ++i) { c = av[i] * c + gv[i]; const float y = c * __uint_as_float((unsigned)yr[i] << 16); YB[gb + (size_t)i * LW] = (bf16)(cvt_pk_bf16(y, 0.f) & 0xffffu); }
          __syncthreads();
          if (sg == 7) carry[col] = c;
        }
        LDS_WAIT(); __syncthreads();
    }
}

__device__ __forceinline__ void p6_convgate(const Args& a, int vcu, int G) {
    const int gt = vcu * (NWAVES * 64) + opaque_tid(), NT = G * NWAVES * 64;
    unsigned char* ws = a.ws; const bf16* UP = (const bf16*)(ws + WS_UP); bf16* Gb = (bf16*)(ws + WS_G);
    constexpr int NCG = FFW / 8, RB = 32, NITEM = NCG * (M / RB);
    const float* cw = a.in[19]; const float* cbv = a.in[20];
    for (int item = gt; item < NITEM; item += NT) {
        const int cg = item % NCG, rb = item / NCG; const int c0 = 8 * cg, row0 = rb * RB; const bool first = (row0 % SEQ) == 0;
        float wg[3][8], wv[3][8], bg[8], bv[8];
#pragma unroll
        for (int k = 0; k < 3; ++k) { const f32x4 g0 = *(const f32x4*)(cw + (size_t)k * UPN + c0), g1 = *(const f32x4*)(cw + (size_t)k * UPN + c0 + 4), v0 = *(const f32x4*)(cw + (size_t)k * UPN + FFW + c0), v1 = *(const f32x4*)(cw + (size_t)k * UPN + FFW + c0 + 4);
#pragma unroll
            for (int j = 0; j < 4; ++j) { wg[k][j] = g0[j]; wg[k][4 + j] = g1[j]; wv[k][j] = v0[j]; wv[k][4 + j] = v1[j]; } }
        { const f32x4 g0 = *(const f32x4*)(cbv + c0), g1 = *(const f32x4*)(cbv + c0 + 4), v0 = *(const f32x4*)(cbv + FFW + c0), v1 = *(const f32x4*)(cbv + FFW + c0 + 4);
#pragma unroll
          for (int j = 0; j < 4; ++j) { bg[j] = g0[j]; bg[4 + j] = g1[j]; bv[j] = v0[j]; bv[4 + j] = v1[j]; } }
        u32x4 g2 = {0u, 0u, 0u, 0u}, g1 = g2, v2 = g2, v1 = g2;
        if (!first) { g2 = *(const u32x4*)(UP + (size_t)(row0 - 2) * UPN + c0); g1 = *(const u32x4*)(UP + (size_t)(row0 - 1) * UPN + c0);
                      v2 = *(const u32x4*)(UP + (size_t)(row0 - 2) * UPN + FFW + c0); v1 = *(const u32x4*)(UP + (size_t)(row0 - 1) * UPN + FFW + c0); }
#pragma unroll 4
        for (int r = 0; r < RB; ++r) { const u32x4 g0 = *(const u32x4*)(UP + (size_t)(row0 + r) * UPN + c0), v0 = *(const u32x4*)(UP + (size_t)(row0 + r) * UPN + FFW + c0);
            const unsigned gw2[4] = {g2.x, g2.y, g2.z, g2.w}, gw1[4] = {g1.x, g1.y, g1.z, g1.w}, gw0[4] = {g0.x, g0.y, g0.z, g0.w}, vw2[4] = {v2.x, v2.y, v2.z, v2.w}, vw1[4] = {v1.x, v1.y, v1.z, v1.w}, vw0[4] = {v0.x, v0.y, v0.z, v0.w};
            float o[8];
#pragma unroll
            for (int p = 0; p < 4; ++p) {
                const float cgl = bg[2 * p] + wg[0][2 * p] * bf_lo(gw2[p]) + wg[1][2 * p] * bf_lo(gw1[p]) + wg[2][2 * p] * bf_lo(gw0[p]);
                const float cgh = bg[2 * p + 1] + wg[0][2 * p + 1] * bf_hi(gw2[p]) + wg[1][2 * p + 1] * bf_hi(gw1[p]) + wg[2][2 * p + 1] * bf_hi(gw0[p]);
                const float cvl = bv[2 * p] + wv[0][2 * p] * bf_lo(vw2[p]) + wv[1][2 * p] * bf_lo(vw1[p]) + wv[2][2 * p] * bf_lo(vw0[p]);
                const float cvh = bv[2 * p + 1] + wv[0][2 * p + 1] * bf_hi(vw2[p]) + wv[1][2 * p + 1] * bf_hi(vw1[p]) + wv[2][2 * p + 1] * bf_hi(vw0[p]);
                o[2 * p] = gelu_tanh_f(cgl) * cvl; o[2 * p + 1] = gelu_tanh_f(cgh) * cvh; }
            u32x4 w; w.x = cvt_pk_bf16(o[0], o[1]); w.y = cvt_pk_bf16(o[2], o[3]); w.z = cvt_pk_bf16(o[4], o[5]); w.w = cvt_pk_bf16(o[6], o[7]);
            *(u32x4*)(Gb + (size_t)(row0 + r) * FFW + c0) = w;
            g2 = g1; g1 = g0; v2 = v1; v1 = v0; }
    }
}

__device__ __forceinline__ void p8_final(const Args& a, int vcu, int G) {
    const int tid = opaque_tid(), lane = tid & 63, gw = vcu * NWAVES + __builtin_amdgcn_readfirstlane(tid >> 6), NGW = G * NWAVES;
    const float* rss = (const float*)(a.ws + WS_CTL) + CW_RSS3; const f32x4* gf = (const f32x4*)a.in[22] + lane;
    for (int m = gw; m < M; m += NGW) { const float rs = 1.0f / sqrtf(rss[m] * (1.0f / DM) + EPS); f32x4* o = (f32x4*)(a.out + (size_t)m * DM) + lane;
#pragma unroll
        for (int j = 0; j < 16; ++j) { const f32x4 v = o[64 * j], g = gf[64 * j]; o[64 * j] = v * rs * g; } }
}

__global__ void __launch_bounds__(NWAVES * 64, 2) hyb_fwd(Args args) {
    extern __shared__ __attribute__((aligned(16))) unsigned char lds_raw[];
    LAS unsigned char* lds = (LAS unsigned char*)lds_raw;
    volatile LAS unsigned* MISC = (volatile LAS unsigned*)(lds + MISC_OFF);
    const int tid = threadIdx.x;
    const int G = gridDim.x; const int bx = blockIdx.x; const int vcu = (G % 8 == 0) ? (bx % 8) * (G / 8) + bx / 8 : bx;
    unsigned char* ws = args.ws;
    unsigned* ctl = (unsigned*)(ws + WS_CTL);
    for (int u = tid; u < (LDS_BYTES - MISC_OFF) / 4; u += NWAVES * 64) ((LAS unsigned*)(lds + MISC_OFF))[u] = 0u;
    __syncthreads();
    XcdBarrier bar; bar.bar = ctl + CW_BAR; bar.x = 0; bar.st = nullptr;
    if (N_LAUNCHES == 1) bar = xcd_barrier_post(ctl + CW_BAR, MISC + 8);
#define GRID_BAR() do { if (N_LAUNCHES == 1) xcd_barrier(bar); } while (0)
    const int lo = args.ph_lo, hi = args.ph_hi;
#ifndef PH_MASK
#define PH_MASK 0x1ff
#endif
#define IN(k) (((PH_MASK >> (k)) & 1) && lo <= (k) && (k) < hi)
#define BOTH(k) (IN(k) && IN((k) + 1))
    float* fctl = (float*)ctl;

    if (IN(0)) { p0_prologue(args, lds, vcu, G); if (BOTH(0)) GRID_BAR(); }

    if (IN(1)) {
        pg8::Gemm g{(const bf16*)(ws + WS_H), (const bf16*)(ws + WS_WIN), M, INC, DM}; pg8::StaticOrder S; S.init(M, INC, G, bx);
        pg8::EpiProj E{(bf16*)(ws + WS_GU), (bf16*)(ws + WS_GV), (bf16*)(ws + WS_XR), (bf16*)(ws + WS_GYR), (bf16*)(ws + WS_SGA), (bf16*)(ws + WS_SGB), fctl + CW_VSUM, fctl + CW_VSQ};
        pg8::gemm_phase<pg8::EpiProj, pg8::StaticOrder, PG8_ALIGN, PG8_SP2>(lds, g, S, E);
        if (BOTH(1)) GRID_BAR();
    }

    if (IN(2)) {
        for (int u = bx; u < NB * LH * 4; u += G) mixer_b_unit(args, lds, u);
        for (int u = bx; u < NB * (SEQ / CHUNK) * 8; u += G) mixer_a_unit(args, lds, u);
        if (BOTH(2)) GRID_BAR();
    }

    if (IN(3)) {
        { pg8::Gemm g{(const bf16*)(ws + WS_YA), (const bf16*)(ws + WS_PA), M, DM, SGW}; pg8::StaticOrder S; S.init(M, DM, G, bx);
          pg8::EpiPA E{(const bf16*)(ws + WS_SGA), (float*)(ws + WS_M1)};
          pg8::gemm_phase<pg8::EpiPA, pg8::StaticOrder, PG8_ALIGN, PG8_SP2>(lds, g, S, E); }
        { pg8::Gemm g{(const bf16*)(ws + WS_YB), (const bf16*)(ws + WS_PB), M, DM, LW}; pg8::StaticOrder S; S.init(M, DM, G, bx);
          pg8::EpiPB E{(const bf16*)(ws + WS_SGB), (const float*)(ws + WS_M1), (bf16*)(ws + WS_MRG)};
          pg8::gemm_phase<pg8::EpiPB, pg8::StaticOrder, PG8_ALIGN, PG8_SP2>(lds, g, S, E); }
        if (BOTH(3)) GRID_BAR();
    }

    if (IN(4)) {
        pg8::Gemm g{(const bf16*)(ws + WS_MRG), (const bf16*)(ws + WS_WOUT), M, DM, DM}; pg8::StaticOrder S; S.init(M, DM, G, bx);
        pg8::EpiResid<true> E{args.in[0], (float*)(ws + WS_X1), (bf16*)(ws + WS_X1B), args.in[17], fctl + CW_RSS2};
        pg8::gemm_phase<pg8::EpiResid<true>, pg8::StaticOrder, PG8_ALIGN, PG8_SP2>(lds, g, S, E);
        if (BOTH(4)) GRID_BAR();
    }

    if (IN(5)) {
        pg8::Gemm g{(const bf16*)(ws + WS_X1B), (const bf16*)(ws + WS_WUP), M, UPN, DM}; pg8::StaticOrder S; S.init(M, UPN, G, bx);
        pg8::EpiUp E{(bf16*)(ws + WS_UP), fctl + CW_RSS2};
        pg8::gemm_phase<pg8::EpiUp, pg8::StaticOrder, PG8_ALIGN, PG8_SP2>(lds, g, S, E);
        if (BOTH(5)) GRID_BAR();
    }

    if (IN(6)) { p6_convgate(args, vcu, G); if (BOTH(6)) GRID_BAR(); }

    if (IN(7)) {
        pg8::Gemm g{(const bf16*)(ws + WS_G), (const bf16*)(ws + WS_WDN), M, DM, FFW}; pg8::StaticOrder S; S.init(M, DM, G, bx);
        pg8::EpiResid<false> E{(const float*)(ws + WS_X1), args.out, nullptr, nullptr, fctl + CW_RSS3};
        pg8::gemm_phase<pg8::EpiResid<false>, pg8::StaticOrder, PG8_ALIGN, PG8_SP2>(lds, g, S, E);
        if (BOTH(7)) GRID_BAR();
    }

    if (IN(8)) p8_final(args, vcu, G);
#undef IN
#undef BOTH
#undef GRID_BAR
}

extern "C" void kernel_launch(void* const* d_in, const int* in_sizes, int n_in, void* d_out, int out_size, void* d_ws, size_t ws_size, hipStream_t stream) {
    static int grid = 0;
    if (grid == 0) {
        if (n_in != 23 || out_size != M * DM || ws_size < WS_END) { fprintf(stderr, "kernel_launch: unexpected shapes (n_in %d, out %d, ws %zu)\n", n_in, out_size, ws_size); grid = -1; return; }
        int dev = 0, cus = 0, per_cu = 0;
        if (hipGetDevice(&dev) != hipSuccess || hipDeviceGetAttribute(&cus, hipDeviceAttributeMultiprocessorCount, dev) != hipSuccess) { grid = -1; return; }
        if (hipFuncSetAttribute((const void*)hyb_fwd, hipFuncAttributeMaxDynamicSharedMemorySize, LDS_BYTES) != hipSuccess) { fprintf(stderr, "kernel_launch: hipFuncSetAttribute failed\n"); grid = -1; return; }
        if (hipOccupancyMaxActiveBlocksPerMultiprocessor(&per_cu, (const void*)hyb_fwd, NWAVES * 64, LDS_BYTES) != hipSuccess || per_cu < 1) { fprintf(stderr, "kernel_launch: occupancy query says %d\n", per_cu); }
        (void)hipGetLastError();
        grid = cus;
    }
    if (grid < 0) return;
    (void)in_sizes;
    (void)hipMemsetAsync((char*)d_ws + WS_CTL, 0, CTL_ZERO_BYTES, stream);
    Args a{};
    for (int i = 0; i < 23; ++i) a.in[i] = (const float*)d_in[i];
    a.out = (float*)d_out; a.ws = (unsigned char*)d_ws;
    if (N_LAUNCHES == 1) { a.ph_lo = 0; a.ph_hi = NPH; hipLaunchKernelGGL(hyb_fwd, dim3(grid), dim3(NWAVES * 64), LDS_BYTES, stream, a); }
    else for (int p = 0; p < NPH; ++p) { a.ph_lo = p; a.ph_hi = p + 1; hipLaunchKernelGGL(hyb_fwd, dim3(grid), dim3(NWAVES * 64), LDS_BYTES, stream, a); }
}
```

```cpp
#include <hip/hip_runtime.h>
#include <cstdio>
#include <cstdint>

#ifndef MK_N_LAUNCHES
#define MK_N_LAUNCHES 1
#endif

namespace pg8 {
#define PG8_LAS __attribute__((address_space(3)))
typedef unsigned short bf16_t;
typedef short bf16x8 __attribute__((ext_vector_type(8)));
typedef float f32x4 __attribute__((ext_vector_type(4)));
typedef unsigned u32x4 __attribute__((ext_vector_type(4)));
typedef unsigned u32x2 __attribute__((ext_vector_type(2)));
constexpr int BM = 256, BK = 64, HALF = 128, HTB = HALF * BK * 2  , STAGE_BYTES = 8 * HTB, NXCD = 8, WGM = 8;

__host__ __device__ __forceinline__ int lds_byte(int r, int c) { const int st = (r >> 4) * 2 + (c >> 5), rr = r & 15, cc = c & 31, ob = rr * 64 + cc * 2; return st * 1024 + (ob ^ (((ob >> 9) & 1) << 5)); }
__host__ __device__ __forceinline__ void stage_rc(int b, int& R, int& C) { const int st = b / 1024, sb = b % 1024, swz = sb ^ (((sb >> 9) & 1) << 5); R = (st >> 1) * 16 + swz / 64; C = (st & 1) * 32 + (swz % 64) / 2; }
__host__ __device__ __forceinline__ int perm32(int rho) { const int n = rho >> 4, i = rho & 15; return 8 * (i >> 2) + 4 * n + (i & 3); }

struct Unit { int pm, pn; };
struct Gemm { const bf16_t* A; const bf16_t* Bt; int M, N, K; };

struct StaticOrder {
    int nM, nN, nwg, G, c;
    __host__ __device__ void init(int M, int N, int G_, int c_) { nM = M / BM; nN = N / BM; nwg = nM * nN; G = G_; c = c_; }
    __host__ __device__ bool next(int i, Unit& u) const {
        const long L = (long)i * G + c; if (L >= nwg) return false;
        int wgid = (int)L; { const int q = nwg / NXCD, r = nwg % NXCD, xcd = wgid % NXCD, off = wgid / NXCD; wgid = (xcd < r ? xcd * (q + 1) : r * (q + 1) + (xcd - r) * q) + off; }
        const int nig = WGM * nN, gid = wgid / nig, fm = gid * WGM, gsz = (nM - fm) < WGM ? (nM - fm) : WGM;
        u.pm = fm + ((wgid % nig) % gsz); u.pn = (wgid % nig) / gsz; return true;
    }
    __device__ __forceinline__ void a_ready(const Unit&) const {}
    __device__ __forceinline__ void done(const Unit&) const {}
};

__device__ __forceinline__ unsigned cvt_pk_bf16(float lo, float hi) { unsigned r; asm volatile("v_cvt_pk_bf16_f32 %0, %1, %2" : "=v"(r) : "v"(lo), "v"(hi)); return r; }
__device__ __forceinline__ float bf_lo(unsigned w) { return __uint_as_float(w << 16); }
__device__ __forceinline__ float bf_hi(unsigned w) { return __uint_as_float(w & 0xffff0000u); }
__device__ __forceinline__ float sigmoid_f(float z) { return __builtin_amdgcn_rcpf(1.0f + __builtin_amdgcn_exp2f(-1.4426950409f * z)); }
__device__ __forceinline__ float gelu_tanh_f(float v) { const float z = 1.5957691216f * (v + 0.044715f * v * v * v); return v * sigmoid_f(z); }


struct EpiProj {
    static constexpr bool PERM = true, AFTER_DRAIN = false, PERMA = false;
    bf16_t *GU, *GV, *XR, *GYR, *SGA, *SGB; float *vsum, *vsq;
    __device__ __forceinline__ void operator()(const f32x4 (&acc)[2][2][4][2], const Unit& u, int wr, int wc, int fr, int fq) const {
        const int pn = u.pn; bf16_t* base; int ldc, colt, act;
        if (pn < 8)       { base = GU;  ldc = 2048; colt = pn * 256;        act = 1; }
        else if (pn < 16) { base = GV;  ldc = 2048; colt = (pn - 8) * 256;  act = 1; }
        else if (pn < 32) { base = XR;  ldc = 4096; colt = (pn - 16) * 256; act = 0; }
        else if (pn < 48) { base = GYR; ldc = 4096; colt = (pn - 32) * 256; act = 1; }
        else if (pn < 64) { base = SGA; ldc = 4096; colt = (pn - 48) * 256; act = 2; }
        else              { base = SGB; ldc = 4096; colt = (pn - 64) * 256; act = 2; }
        const bool st = (pn >= 8) && (pn < 16);
        const int row0 = u.pm * BM + wr * 64 + fr, col0 = colt + wc * 32 + 8 * fq;
#pragma unroll
        for (int ai = 0; ai < 2; ++ai)
#pragma unroll
            for (int m = 0; m < 4; ++m) { const int row = row0 + ai * HALF + m * 16; bf16_t* rowp = base + (size_t)row * ldc + col0; float s = 0.f, q = 0.f;
#pragma unroll
                for (int bj = 0; bj < 2; ++bj) { f32x4 v0 = acc[ai][bj][m][0], v1 = acc[ai][bj][m][1];
                    if (act == 1) {
#pragma unroll
                        for (int j = 0; j < 4; ++j) { v0[j] = gelu_tanh_f(v0[j]); v1[j] = gelu_tanh_f(v1[j]); } }
                    else if (act == 2) {
#pragma unroll
                        for (int j = 0; j < 4; ++j) { v0[j] = sigmoid_f(v0[j]); v1[j] = sigmoid_f(v1[j]); } }
                    if (st) {
#pragma unroll
                        for (int j = 0; j < 4; ++j) { s += v0[j] + v1[j]; q += v0[j] * v0[j] + v1[j] * v1[j]; } }
                    u32x4 w; w.x = cvt_pk_bf16(v0[0], v0[1]); w.y = cvt_pk_bf16(v0[2], v0[3]); w.z = cvt_pk_bf16(v1[0], v1[1]); w.w = cvt_pk_bf16(v1[2], v1[3]);
                    *(u32x4*)(rowp + bj * HALF) = w; }
                if (st) { s += __shfl_xor(s, 16); s += __shfl_xor(s, 32); q += __shfl_xor(q, 16); q += __shfl_xor(q, 32);
                    if (fq == 0) { unsafeAtomicAdd(vsum + row, s); unsafeAtomicAdd(vsq + row, q); } } }
    }
};
struct EpiPA {
    static constexpr bool PERM = true, AFTER_DRAIN = false, PERMA = false;
    const bf16_t* SG; float* M1;
    __device__ __forceinline__ void operator()(const f32x4 (&acc)[2][2][4][2], const Unit& u, int wr, int wc, int fr, int fq) const {
        const int row0 = u.pm * BM + wr * 64 + fr, col0 = u.pn * BM + wc * 32 + 8 * fq;
#pragma unroll
        for (int ai = 0; ai < 2; ++ai)
#pragma unroll
            for (int m = 0; m < 4; ++m) { const size_t off = (size_t)(row0 + ai * HALF + m * 16) * 4096 + col0;
#pragma unroll
                for (int bj = 0; bj < 2; ++bj) { const u32x4 g = *(const u32x4*)(SG + off + bj * HALF); const f32x4 a0 = acc[ai][bj][m][0], a1 = acc[ai][bj][m][1];
                    f32x4 o0, o1; o0[0] = a0[0] * bf_lo(g.x); o0[1] = a0[1] * bf_hi(g.x); o0[2] = a0[2] * bf_lo(g.y); o0[3] = a0[3] * bf_hi(g.y);
                    o1[0] = a1[0] * bf_lo(g.z); o1[1] = a1[1] * bf_hi(g.z); o1[2] = a1[2] * bf_lo(g.w); o1[3] = a1[3] * bf_hi(g.w);
                    *(f32x4*)(M1 + off + bj * HALF) = o0; *(f32x4*)(M1 + off + bj * HALF + 4) = o1; } }
    }
};
struct EpiPB {
    static constexpr bool PERM = true, AFTER_DRAIN = false, PERMA = false;
    const bf16_t* SG; const float* M1; bf16_t* O;
    __device__ __forceinline__ void operator()(const f32x4 (&acc)[2][2][4][2], const Unit& u, int wr, int wc, int fr, int fq) const {
        const int row0 = u.pm * BM + wr * 64 + fr, col0 = u.pn * BM + wc * 32 + 8 * fq;
#pragma unroll
        for (int ai = 0; ai < 2; ++ai)
#pragma unroll
            for (int m = 0; m < 4; ++m) { const size_t off = (size_t)(row0 + ai * HALF + m * 16) * 4096 + col0;
#pragma unroll
                for (int bj = 0; bj < 2; ++bj) { const u32x4 g = *(const u32x4*)(SG + off + bj * HALF); const f32x4 a0 = acc[ai][bj][m][0], a1 = acc[ai][bj][m][1];
                    const f32x4 p0 = *(const f32x4*)(M1 + off + bj * HALF), p1 = *(const f32x4*)(M1 + off + bj * HALF + 4);
                    u32x4 w; w.x = cvt_pk_bf16(p0[0] + a0[0] * bf_lo(g.x), p0[1] + a0[1] * bf_hi(g.x)); w.y = cvt_pk_bf16(p0[2] + a0[2] * bf_lo(g.y), p0[3] + a0[3] * bf_hi(g.y));
                    w.z = cvt_pk_bf16(p1[0] + a1[0] * bf_lo(g.z), p1[1] + a1[1] * bf_hi(g.z)); w.w = cvt_pk_bf16(p1[2] + a1[2] * bf_lo(g.w), p1[3] + a1[3] * bf_hi(g.w));
                    *(u32x4*)(O + off + bj * HALF) = w; } }
    }
};
template <bool WITH_B> struct EpiResid {
    static constexpr bool PERM = true, AFTER_DRAIN = false, PERMA = false;
    const float* XI; float* XO; bf16_t* XB; const float* gain; float* rowss;
    __device__ __forceinline__ void operator()(const f32x4 (&acc)[2][2][4][2], const Unit& u, int wr, int wc, int fr, int fq) const {
        const int row0 = u.pm * BM + wr * 64 + fr, col0 = u.pn * BM + wc * 32 + 8 * fq;
        f32x4 gv[2][2];
        if (WITH_B) {
#pragma unroll
            for (int bj = 0; bj < 2; ++bj) { gv[bj][0] = *(const f32x4*)(gain + col0 + bj * HALF); gv[bj][1] = *(const f32x4*)(gain + col0 + bj * HALF + 4); } }
#pragma unroll
        for (int ai = 0; ai < 2; ++ai)
#pragma unroll
            for (int m = 0; m < 4; ++m) { const int row = row0 + ai * HALF + m * 16; const size_t off = (size_t)row * 4096 + col0; float q = 0.f;
#pragma unroll
                for (int bj = 0; bj < 2; ++bj) { const f32x4 x0 = *(const f32x4*)(XI + off + bj * HALF) + acc[ai][bj][m][0], x1 = *(const f32x4*)(XI + off + bj * HALF + 4) + acc[ai][bj][m][1];
                    *(f32x4*)(XO + off + bj * HALF) = x0; *(f32x4*)(XO + off + bj * HALF + 4) = x1;
#pragma unroll
                    for (int j = 0; j < 4; ++j) q += x0[j] * x0[j] + x1[j] * x1[j];
                    if (WITH_B) { const f32x4 y0 = x0 * gv[bj][0], y1 = x1 * gv[bj][1]; u32x4 w; w.x = cvt_pk_bf16(y0[0], y0[1]); w.y = cvt_pk_bf16(y0[2], y0[3]); w.z = cvt_pk_bf16(y1[0], y1[1]); w.w = cvt_pk_bf16(y1[2], y1[3]);
                        *(u32x4*)(XB + off + bj * HALF) = w; } }
                q += __shfl_xor(q, 16); q += __shfl_xor(q, 32);
                if (fq == 0) unsafeAtomicAdd(rowss + row, q); }
    }
};
__device__ __forceinline__ float dpp_shr1(float old, float x) { return __int_as_float(__builtin_amdgcn_update_dpp(__float_as_int(old), __float_as_int(x), 0x111, 0xf, 0xf, false)); }
__device__ __forceinline__ float gelu_mul(float g, float v) {
    const float t = g * (-2.3022082f + -0.10294324f * g * g);
    return g * v * __builtin_amdgcn_rcpf(1.0f + __builtin_amdgcn_exp2f(t)); }
struct EpiUpGate {
    static constexpr bool PERM = true, AFTER_DRAIN = false, PERMA = true;
    bf16_t* G; const float* rowss; const float* cw; const float* cb; float* HEAD; float* TAIL; PG8_LAS float* halo;
    __device__ __forceinline__ void operator()(f32x4 (&acc)[2][2][4][2], const Unit& u, int wr, int wc, int fr, int fq) const {
        const int row0 = u.pm * BM + wr * 64 + 4 * fr;
        const int cbase = u.pn * 128 + wc * 32 + 8 * fq;
        f32x4 wg[3], wv[3], bg, bv;
#pragma unroll
        for (int k = 0; k < 3; ++k) { wg[k] = *(const f32x4*)(cw + (size_t)k * 24576 + cbase); wv[k] = *(const f32x4*)(cw + (size_t)k * 24576 + 12288 + cbase); }
        bg = *(const f32x4*)(cb + cbase); bv = *(const f32x4*)(cb + 12288 + cbase);
#pragma unroll
        for (int ai = 0; ai < 2; ++ai) { const f32x4 q = *(const f32x4*)(rowss + row0 + ai * HALF);
#pragma unroll
            for (int m = 0; m < 4; ++m) { const float rs = 1.0f / sqrtf(q[m] * (1.0f / 4096.0f) + 1e-6f);
#pragma unroll
                for (int bj = 0; bj < 2; ++bj) { acc[ai][bj][m][0] *= rs; acc[ai][bj][m][1] *= rs; } } }
        const size_t tb = ((size_t)(u.pm * 96 + u.pn) * 2) * 256;
#pragma unroll
        for (int ai = 0; ai < 2; ++ai) { const int blk = 2 * ai + wr;
            if (fr == 15) {
#pragma unroll
                for (int bj = 0; bj < 2; ++bj)
#pragma unroll
                    for (int n = 0; n < 2; ++n)
#pragma unroll
                        for (int mm = 0; mm < 2; ++mm) { const f32x4 v = acc[ai][bj][2 + mm][n];
#pragma unroll
                            for (int e = 0; e < 4; ++e) halo[((blk * 4 + wc) * 4 + fq) * 32 + (bj * 8 + n * 4 + e) * 2 + mm] = v[e];
                            if (blk == 3) *(f32x4*)(TAIL + tb + (size_t)mm * 256 + bj * HALF + wc * 32 + 8 * fq + 4 * n) = v; } }
            if (blk == 0 && fr == 0) {
#pragma unroll
                for (int bj = 0; bj < 2; ++bj)
#pragma unroll
                    for (int n = 0; n < 2; ++n)
#pragma unroll
                        for (int mm = 0; mm < 2; ++mm) *(f32x4*)(HEAD + tb + (size_t)mm * 256 + bj * HALF + wc * 32 + 8 * fq + 4 * n) = acc[0][bj][mm][n]; } }
        asm volatile("s_waitcnt lgkmcnt(0)" ::: "memory"); __builtin_amdgcn_s_barrier(); asm volatile("" ::: "memory");
#pragma unroll
        for (int n = 0; n < 2; ++n) {
            if (n == 1) {
#pragma unroll
                for (int k = 0; k < 3; ++k) { wg[k] = *(const f32x4*)(cw + (size_t)k * 24576 + cbase + 4); wv[k] = *(const f32x4*)(cw + (size_t)k * 24576 + 12288 + cbase + 4); }
                bg = *(const f32x4*)(cb + cbase + 4); bv = *(const f32x4*)(cb + 12288 + cbase + 4); }
#pragma unroll
            for (int ai = 0; ai < 2; ++ai) { const int blk = 2 * ai + wr; const int pblk = blk > 0 ? blk - 1 : 0; const float hz = blk > 0 ? 1.0f : 0.0f;
                f32x4 q2[2], q3[2];
#pragma unroll
                for (int bj = 0; bj < 2; ++bj) {
                    const PG8_LAS f32x4* hp = (const PG8_LAS f32x4*)(halo + ((pblk * 4 + wc) * 4 + fq) * 32 + (bj * 8 + n * 4) * 2);
                    const f32x4 ha = hp[0] * hz, hb = hp[1] * hz;
                    q2[bj][0] = dpp_shr1(ha[0], acc[ai][bj][2][n][0]); q3[bj][0] = dpp_shr1(ha[1], acc[ai][bj][3][n][0]);
                    q2[bj][1] = dpp_shr1(ha[2], acc[ai][bj][2][n][1]); q3[bj][1] = dpp_shr1(ha[3], acc[ai][bj][3][n][1]);
                    q2[bj][2] = dpp_shr1(hb[0], acc[ai][bj][2][n][2]); q3[bj][2] = dpp_shr1(hb[1], acc[ai][bj][3][n][2]);
                    q2[bj][3] = dpp_shr1(hb[2], acc[ai][bj][2][n][3]); q3[bj][3] = dpp_shr1(hb[3], acc[ai][bj][3][n][3]); }
#pragma unroll
                for (int m = 0; m < 4; ++m) { const int row = row0 + ai * HALF + m;
                    const f32x4 s1g = (m == 0) ? q3[0] : acc[ai][0][m > 0 ? m - 1 : 0][n], s2g = (m == 0) ? q2[0] : (m == 1) ? q3[0] : acc[ai][0][m > 1 ? m - 2 : 0][n];
                    const f32x4 s1v = (m == 0) ? q3[1] : acc[ai][1][m > 0 ? m - 1 : 0][n], s2v = (m == 0) ? q2[1] : (m == 1) ? q3[1] : acc[ai][1][m > 1 ? m - 2 : 0][n];
                    const f32x4 cgt = bg + wg[0] * s2g + wg[1] * s1g + wg[2] * acc[ai][0][m][n], cvl = bv + wv[0] * s2v + wv[1] * s1v + wv[2] * acc[ai][1][m][n];
                    float o[4];
#pragma unroll
                    for (int e = 0; e < 4; ++e) o[e] = gelu_mul(cgt[e], cvl[e]);
                    u32x2 w; w.x = cvt_pk_bf16(o[0], o[1]); w.y = cvt_pk_bf16(o[2], o[3]);
                    *(u32x2*)(G + (size_t)row * 12288 + cbase + 4 * n) = w; } } }
    }
};

template <class Epi, class Sched, bool ALIGN_EPI = false, bool SP2 = false>
__device__ __forceinline__ void gemm_phase(PG8_LAS unsigned char* lds, const Gemm g, const Sched& S, const Epi& E) {
    int tid = threadIdx.x; asm volatile("" : "+v"(tid));
    const int wid = __builtin_amdgcn_readfirstlane(tid >> 6), lane = tid & 63, wr = wid >> 2, wc = wid & 3, fr = lane & 15, fq = lane >> 4;
    const int K = g.K, nt = K / BK;
    unsigned voffA[2], voffB[2];
#pragma unroll
    for (int i = 0; i < 2; ++i) { int R, C; stage_rc(tid * 16 + i * 8192, R, C); const int Rb = Epi::PERM ? ((R & ~31) + perm32(R & 31)) : R;
        const int Ra = Epi::PERMA ? ((R & 64) + 4 * (R & 15) + ((R >> 4) & 3)) : R;
        voffA[i] = (unsigned)(Ra * K + C) * 2u; voffB[i] = (unsigned)(Rb * K + C) * 2u; }
    const size_t kstep = (size_t)(BK * 2);
    const size_t hstep = (size_t)HALF * K * 2;
    const size_t tstep = 2 * hstep;
    const unsigned ldsw = (unsigned)wid * 1024u;
    const int aoff = lds_byte(wr * 64 + fr, fq * 8), boff = lds_byte(wc * 32 + fr, fq * 8);
#define PG8_SA(b, h) (((b) * 2 + (h)) * HTB)
#define PG8_SB(b, h) ((4 + (b) * 2 + (h)) * HTB)
#define PG8_STAGE(bufoff, gbase, voff) do { _Pragma("unroll") for (int _i = 0; _i < 2; ++_i) \
        __builtin_amdgcn_global_load_lds((const unsigned*)((const char*)(gbase) + (voff)[_i]), (PG8_LAS unsigned*)(lds + (bufoff) + ldsw + _i * 8192), 16, 0, 0); } while (0)
#define PG8_LDA(dst, b, h) do { _Pragma("unroll") for (int m = 0; m < 4; ++m) _Pragma("unroll") for (int k = 0; k < 2; ++k) dst[m][k] = *(const PG8_LAS bf16x8*)(lds + PG8_SA(b, h) + aoff + m * 2048 + k * 1024); } while (0)
#define PG8_LDB(dst, b, h) do { _Pragma("unroll") for (int n = 0; n < 2; ++n) _Pragma("unroll") for (int k = 0; k < 2; ++k) dst[n][k] = *(const PG8_LAS bf16x8*)(lds + PG8_SB(b, h) + boff + n * 2048 + k * 1024); } while (0)
#define PG8_MMA(ai, bj, At, Bt) do { __builtin_amdgcn_s_setprio(1); _Pragma("unroll") for (int m = 0; m < 4; ++m) _Pragma("unroll") for (int n = 0; n < 2; ++n) _Pragma("unroll") for (int k = 0; k < 2; ++k) \
        acc[ai][bj][m][n] = __builtin_amdgcn_mfma_f32_16x16x32_bf16(Bt[n][k], At[m][k], acc[ai][bj][m][n], 0, 0, 0); __builtin_amdgcn_s_setprio(0); } while (0)
#define PG8_WAIT_V(n) asm volatile("s_waitcnt vmcnt(" #n ")" ::: "memory")
#define PG8_WAIT_L(n) asm volatile("s_waitcnt lgkmcnt(" #n ")" ::: "memory")
#define PG8_BAR __builtin_amdgcn_s_barrier()
#define PG8_SCHED __builtin_amdgcn_sched_barrier(0)
    Unit cur, nxt; int ui = 0;
    if (!S.next(0, cur)) return;
    f32x4 acc[2][2][4][2];
#pragma unroll
    for (int a = 0; a < 2; ++a)
#pragma unroll
        for (int b = 0; b < 2; ++b)
#pragma unroll
            for (int m = 0; m < 4; ++m)
#pragma unroll
                for (int n = 0; n < 2; ++n) acc[a][b][m][n] = (f32x4){0.f, 0.f, 0.f, 0.f};
    bf16x8 At[4][2], B0[2][2], B1[2][2];
    const char* cA = (const char*)g.A + (size_t)cur.pm * tstep; const char* cB = (const char*)g.Bt + (size_t)cur.pn * tstep;
    S.a_ready(cur);
    if constexpr (SP2) {
        PG8_STAGE(PG8_SB(0, 0), cB, voffB); PG8_STAGE(PG8_SB(0, 1), cB + hstep, voffB); PG8_STAGE(PG8_SA(0, 0), cA, voffA); PG8_STAGE(PG8_SA(0, 1), cA + hstep, voffA);
        if (wr == 1) PG8_BAR;
        PG8_WAIT_V(2); PG8_BAR;
        PG8_STAGE(PG8_SB(1, 0), cB + kstep, voffB); PG8_STAGE(PG8_SA(1, 0), cA + kstep, voffA); PG8_STAGE(PG8_SB(1, 1), cB + hstep + kstep, voffB);
        PG8_WAIT_V(6); PG8_BAR;
    } else {
        PG8_STAGE(PG8_SB(0, 0), cB, voffB); PG8_STAGE(PG8_SA(0, 0), cA, voffA); PG8_STAGE(PG8_SB(0, 1), cB + hstep, voffB); PG8_STAGE(PG8_SA(0, 1), cA + hstep, voffA);
        if (wr == 1) PG8_BAR;
        PG8_WAIT_V(4); PG8_BAR;
        PG8_STAGE(PG8_SB(1, 0), cB + kstep, voffB); PG8_STAGE(PG8_SA(1, 0), cA + kstep, voffA); PG8_STAGE(PG8_SB(1, 1), cB + hstep + kstep, voffB);
        PG8_WAIT_V(6); PG8_BAR;
    }
    for (;;) {
        const bool has_next = S.next(ui + 1, nxt);
        const char* nA = has_next ? (const char*)g.A + (size_t)nxt.pm * tstep : cA; const char* nB = has_next ? (const char*)g.Bt + (size_t)nxt.pn * tstep : cB;
        for (int t = 0; t < nt; t += 2) {
            const bool last = (t == nt - 2);
            const char* a1 = cA + (size_t)(t + 1) * kstep;
            const char* a2 = last ? nA : cA + (size_t)(t + 2) * kstep; const char* b2 = last ? nB : cB + (size_t)(t + 2) * kstep;
            const char* a3 = a2 + kstep; const char* b3 = b2 + kstep;
            if (last && has_next) S.a_ready(nxt);
            if constexpr (SP2) {
            PG8_LDB(B0, 0, 0); PG8_LDB(B1, 0, 1); PG8_SCHED; PG8_LDA(At, 0, 0); PG8_STAGE(PG8_SA(1, 1), a1 + hstep, voffA);
            PG8_WAIT_V(8); PG8_WAIT_L(0); PG8_BAR; PG8_MMA(0, 0, At, B0); PG8_MMA(0, 1, At, B1); PG8_BAR; PG8_SCHED;
            PG8_LDA(At, 0, 1); PG8_STAGE(PG8_SB(0, 0), b2, voffB); PG8_STAGE(PG8_SB(0, 1), b2 + hstep, voffB); PG8_STAGE(PG8_SA(0, 0), a2, voffA);
            PG8_WAIT_V(8); PG8_WAIT_L(0); PG8_BAR; PG8_MMA(1, 0, At, B0); PG8_MMA(1, 1, At, B1); PG8_BAR; PG8_SCHED;
            PG8_LDB(B0, 1, 0); PG8_LDB(B1, 1, 1); PG8_SCHED; PG8_LDA(At, 1, 0); PG8_STAGE(PG8_SA(0, 1), a2 + hstep, voffA);
            PG8_WAIT_V(8); PG8_WAIT_L(0); PG8_BAR; PG8_MMA(0, 0, At, B0); PG8_MMA(0, 1, At, B1); PG8_BAR; PG8_SCHED;
            PG8_LDA(At, 1, 1); PG8_STAGE(PG8_SB(1, 0), b3, voffB); PG8_STAGE(PG8_SB(1, 1), b3 + hstep, voffB); PG8_STAGE(PG8_SA(1, 0), a3, voffA);
            PG8_WAIT_V(8); PG8_WAIT_L(0); PG8_BAR; PG8_MMA(1, 0, At, B0); PG8_MMA(1, 1, At, B1); PG8_BAR; PG8_SCHED;
            } else {
            PG8_LDB(B0, 0, 0); PG8_SCHED; PG8_LDA(At, 0, 0); PG8_STAGE(PG8_SA(1, 1), a1 + hstep, voffA);
            PG8_WAIT_L(8); PG8_BAR; PG8_WAIT_L(0); PG8_MMA(0, 0, At, B0); PG8_BAR; PG8_SCHED;
            PG8_LDB(B1, 0, 1); PG8_STAGE(PG8_SB(0, 0), b2, voffB);
            PG8_BAR; PG8_WAIT_L(0); PG8_MMA(0, 1, At, B1); PG8_BAR;
            PG8_LDA(At, 0, 1); PG8_STAGE(PG8_SA(0, 0), a2, voffA);
            PG8_BAR; PG8_WAIT_L(0); PG8_MMA(1, 0, At, B0); PG8_BAR; PG8_SCHED;
            PG8_STAGE(PG8_SB(0, 1), b2 + hstep, voffB);
            PG8_WAIT_V(6); PG8_BAR; PG8_MMA(1, 1, At, B1); PG8_BAR;
            PG8_LDB(B0, 1, 0); PG8_SCHED; PG8_LDA(At, 1, 0); PG8_STAGE(PG8_SA(0, 1), a2 + hstep, voffA);
            PG8_WAIT_L(8); PG8_BAR; PG8_WAIT_L(0); PG8_MMA(0, 0, At, B0); PG8_BAR; PG8_SCHED;
            PG8_LDB(B1, 1, 1); PG8_STAGE(PG8_SB(1, 0), b3, voffB);
            PG8_BAR; PG8_WAIT_L(0); PG8_MMA(0, 1, At, B1); PG8_BAR;
            PG8_LDA(At, 1, 1); PG8_STAGE(PG8_SA(1, 0), a3, voffA);
            PG8_BAR; PG8_WAIT_L(0); PG8_MMA(1, 0, At, B0); PG8_BAR; PG8_SCHED;
            PG8_STAGE(PG8_SB(1, 1), b3 + hstep, voffB);
            PG8_WAIT_V(6); PG8_BAR; PG8_MMA(1, 1, At, B1); PG8_BAR;
            }
        }
        if constexpr (ALIGN_EPI) { if (wr == 0) PG8_BAR; }
        E(acc, cur, wr, wc, fr, fq); S.done(cur);
        if (!has_next) break;
#pragma unroll
        for (int a = 0; a < 2; ++a)
#pragma unroll
            for (int b = 0; b < 2; ++b)
#pragma unroll
                for (int m = 0; m < 4; ++m)
#pragma unroll
                    for (int n = 0; n < 2; ++n) acc[a][b][m][n] = (f32x4){0.f, 0.f, 0.f, 0.f};
        cur = nxt; cA = nA; cB = nB; ++ui;
        if constexpr (ALIGN_EPI) { if (wr == 1) PG8_BAR; }
    }
    PG8_WAIT_V(0);
    if constexpr (!ALIGN_EPI) { if (wr == 0) PG8_BAR; }
    PG8_BAR;
#undef PG8_SA
#undef PG8_SB
#undef PG8_STAGE
#undef PG8_LDA
#undef PG8_LDB
#undef PG8_MMA
#undef PG8_WAIT_V
#undef PG8_WAIT_L
#undef PG8_BAR
#undef PG8_SCHED
}
}

#ifndef PG8_SP2
#define PG8_SP2 true
#endif
#ifndef PG8_ALIGN
#define PG8_ALIGN true
#endif

constexpr int NWAVES = 8;
constexpr int N_LAUNCHES = MK_N_LAUNCHES;
constexpr int NPH = 9;
constexpr int DM = 4096, SEQ = 2048, NB = 4, M = NB * SEQ;
constexpr int SGW = 2048, SGD = 256, CHUNK = 128;
constexpr int LW = 4096, LH = 16, LHD = 256;
constexpr int FFW = 12288, UPN = 2 * FFW, INC = 20480;
constexpr float EPS = 1e-6f;

constexpr size_t MiB = 1u << 20;
constexpr size_t WS_CTL = 0, CTL_ZERO_BYTES = 1 * MiB;
constexpr size_t WS_WIN = 2 * MiB, WS_WUP = 162 * MiB, WS_WDN = 354 * MiB, WS_PA = 450 * MiB, WS_PB = 466 * MiB, WS_WOUT = 498 * MiB, WS_WA = 530 * MiB, WS_WX = 532 * MiB;
constexpr size_t WS_H = 536 * MiB, WS_GU = 600 * MiB, WS_GV = 632 * MiB, WS_XR = 664 * MiB, WS_GYR = 728 * MiB, WS_SGA = 792 * MiB, WS_SGB = 856 * MiB;
constexpr size_t WS_YA = 920 * MiB, WS_YB = 952 * MiB, WS_M1 = 1016 * MiB, WS_MRG = 1144 * MiB, WS_X1 = 1208 * MiB, WS_X1B = 1336 * MiB, WS_END = 1400 * MiB;
constexpr size_t WS_HEAD = 536 * MiB, WS_TAIL = 544 * MiB;
constexpr size_t WS_G = 920 * MiB;
static_assert(WS_TAIL + (size_t)32 * 96 * 2 * 256 * 4 <= WS_GU && WS_G + (size_t)M * FFW * 2 <= WS_MRG, "overlay map");
constexpr int CW_TMO = 0;
constexpr int CW_BAR = 4096;
constexpr int CW_VSUM = 16384, CW_VSQ = CW_VSUM + M, CW_RSS2 = CW_VSQ + M, CW_RSS3 = CW_RSS2 + M, CW_DUMMY = CW_RSS3 + M;
static_assert((CW_DUMMY + 2 * M) * 4 <= (int)CTL_ZERO_BYTES, "CTL words inside the memset region");

constexpr int LDS_BYTES = 155648;
constexpr int MISC_OFF = 154624;
constexpr int HALO_OFF = 131072;

#define LAS __attribute__((address_space(3)))
typedef unsigned short bf16;
typedef float f32x4 __attribute__((ext_vector_type(4)));
typedef unsigned u32x4 __attribute__((ext_vector_type(4)));
typedef unsigned u32x2 __attribute__((ext_vector_type(2)));
typedef short bf16x8 __attribute__((ext_vector_type(8)));
#define LDS_WAIT() asm volatile("s_waitcnt lgkmcnt(0)" ::: "memory")
#define VM_WAIT() asm volatile("s_waitcnt vmcnt(0)" ::: "memory")
#define LDS_BARRIER() do { asm volatile("s_waitcnt lgkmcnt(0)" ::: "memory"); __builtin_amdgcn_s_barrier(); asm volatile("" ::: "memory"); } while (0)
using pg8::cvt_pk_bf16; using pg8::bf_lo; using pg8::bf_hi; using pg8::sigmoid_f; using pg8::gelu_tanh_f;

#define XB_TMO      128
#define XB_XCNT(j)  (256  + 64 * (j))
#define XB_XSUB(j)  (1280 + 64 * (j))
#define XB_XGEN(j)  (2304 + 64 * (j))
#define XB_TOP      3328
#define XB_TOPGEN   3392
#define XCD_BAR_WORDS 3456
#define XB_SPIN_CAP (1u << 18)
__device__ __forceinline__ unsigned xb_ld(unsigned* p)              { return __hip_atomic_load(p, __ATOMIC_RELAXED, __HIP_MEMORY_SCOPE_AGENT); }
__device__ __forceinline__ unsigned xb_add(unsigned* p, unsigned v) { return __hip_atomic_fetch_add(p, v, __ATOMIC_RELAXED, __HIP_MEMORY_SCOPE_AGENT); }
__device__ __forceinline__ unsigned xb_xcc_id() { return (unsigned)__builtin_amdgcn_s_getreg((3 << 11) | 20) & 0xFu; }
#define XB_SPIN(cond, bar) do { unsigned _sp = 0; while (cond) { __builtin_amdgcn_s_sleep(1); \
    if ((++_sp & 255u) == 0u) { if (xb_ld(&(bar)[XB_TMO])) break; if (_sp > XB_SPIN_CAP) { atomicAdd(&(bar)[XB_TMO], 1u); break; } } } } while (0)
struct XcdBarrier { unsigned* bar; unsigned x; volatile LAS unsigned* st; };
__device__ __forceinline__ XcdBarrier xcd_barrier_post(unsigned* bar, volatile LAS unsigned* st) {
    XcdBarrier b; b.bar = bar; b.x = xb_xcc_id(); b.st = st;
    if (threadIdx.x == 0) (void)xb_add(&bar[XB_XCNT(b.x)], 1u);
    return b;
}
__device__ __forceinline__ void xcd_barrier_complete(unsigned* bar, unsigned x, unsigned& nloc, unsigned& nx) {
    const unsigned G = gridDim.x * gridDim.y * gridDim.z;
    unsigned sum, cnt, mine, sp = 0u;
    for (;;) {
        sum = 0u; cnt = 0u; mine = 0u;
#pragma unroll
        for (unsigned j = 0; j < 16; ++j) { const unsigned c = xb_ld(&bar[XB_XCNT(j)]); sum += c; cnt += (c > 0u) ? 1u : 0u; mine = (j == x) ? c : mine; }
        if (sum == G) break;
        __builtin_amdgcn_s_sleep(1);
        if ((++sp & 255u) == 0u) { if (xb_ld(&bar[XB_TMO])) break; if (sp > XB_SPIN_CAP) { atomicAdd(&bar[XB_TMO], 1u); break; } }
    }
    nloc = mine > 0u ? mine : 1u; nx = cnt > 0u ? cnt : 1u;
}
__device__ __forceinline__ void xcd_barrier(const XcdBarrier& b) {
    asm volatile("s_waitcnt vmcnt(0)" ::: "memory");
    __syncthreads();
    if (threadIdx.x == 0) {
        unsigned* bar = b.bar;
        __builtin_amdgcn_s_waitcnt(0);
        unsigned nloc = b.st[0], nx = b.st[1];
        if (nloc == 0u) { xcd_barrier_complete(bar, b.x, nloc, nx); b.st[0] = nloc; b.st[1] = nx; }
        const unsigned old = xb_add(&bar[XB_XSUB(b.x)], 1u);
        const unsigned gen = old / nloc;
        if (old + 1u == (gen + 1u) * nloc) {
            __builtin_amdgcn_fence(__ATOMIC_RELEASE, "agent");
            asm volatile("s_waitcnt vmcnt(0)" ::: "memory");
            const unsigned og = xb_add(&bar[XB_TOP], 1u);
            const unsigned tg = og / nx;
            if (og + 1u == (tg + 1u) * nx) xb_add(&bar[XB_TOPGEN], 1u);
            else XB_SPIN(xb_ld(&bar[XB_TOPGEN]) == tg, bar);
            __builtin_amdgcn_fence(__ATOMIC_ACQUIRE, "agent");
            xb_add(&bar[XB_XGEN(b.x)], 1u);
            asm volatile("s_waitcnt vmcnt(0)" ::: "memory");
        } else {
            XB_SPIN(xb_ld(&bar[XB_XGEN(b.x)]) == gen, bar);
            __builtin_amdgcn_fence(__ATOMIC_ACQUIRE, "agent");
            asm volatile("s_waitcnt vmcnt(0)" ::: "memory");
        }
    }
    __syncthreads();
}

__device__ __forceinline__ int opaque_tid() { int t = threadIdx.x; asm volatile("" : "+v"(t)); return t; }
__device__ __forceinline__ float wave_sum(float v) {
#pragma unroll
    for (int o = 1; o < 64; o <<= 1) v += __shfl_xor(v, o);
    return v;
}
__device__ __forceinline__ void tr_tile(const float* __restrict__ W, int ldw, bf16* __restrict__ WT, int ldt, int k0, int n0, int dn0, LAS unsigned* scr, int lane) {
    const int nl = (lane & 15) * 4, kq = lane >> 4;
    f32x4 v[16];
#pragma unroll
    for (int i = 0; i < 8; ++i)
#pragma unroll
        for (int h = 0; h < 2; ++h) v[2 * i + h] = *(const f32x4*)(W + (size_t)(k0 + 8 * i + 2 * kq + h) * ldw + n0 + nl);
#pragma unroll
    for (int i = 0; i < 8; ++i)
#pragma unroll
        for (int j = 0; j < 4; ++j) scr[(nl + j) * 33 + 4 * i + kq] = cvt_pk_bf16(v[2 * i][j], v[2 * i + 1][j]);
    LDS_WAIT(); asm volatile("" ::: "memory");
    const int c = lane & 7, nr = lane >> 3;
#pragma unroll
    for (int it = 0; it < 8; ++it) { const int n = 8 * it + nr; const LAS unsigned* s = scr + n * 33 + 4 * c;
        u32x4 o; o.x = s[0]; o.y = s[1]; o.z = s[2]; o.w = s[3];
        *(u32x4*)(WT + (size_t)(dn0 + n) * ldt + k0 + 8 * c) = o; }
    LDS_WAIT(); asm volatile("" ::: "memory");
}

struct Args { const float* in[23]; float* out; unsigned char* ws; int ph_lo, ph_hi; };

__device__ __forceinline__ void p0_prologue(const Args& a, LAS unsigned char* lds, int vcu, int G) {
    const int tid = opaque_tid(), lane = tid & 63, wave = __builtin_amdgcn_readfirstlane(tid >> 6);
    unsigned char* ws = a.ws;
    LAS unsigned* scr = (LAS unsigned*)(lds + wave * 8448);
    const int gw = vcu * NWAVES + wave, NGW = G * NWAVES;
    constexpr int T_IN = (DM / 64) * (INC / 64), T_UP = (DM / 64) * (UPN / 64), T_DN = (FFW / 64) * (DM / 64), T_PA = (SGW / 64) * (DM / 64), T_PB = (LW / 64) * (DM / 64), T_WO = (DM / 64) * (DM / 64), T_G = LH * 16;
    constexpr int NT = T_IN + T_UP + T_DN + T_PA + T_PB + T_WO + 2 * T_G;
    for (int it = gw; it < NT; it += NGW) {
        int r = it;
        if (r < T_IN) { const int nb = INC / 64; tr_tile(a.in[2], INC, (bf16*)(ws + WS_WIN), DM, 64 * (r / nb), 64 * (r % nb), 64 * (r % nb), scr, lane); continue; } r -= T_IN;
        if (r < T_UP) { const int nb = UPN / 64; const int n0 = 64 * (r % nb); const int ch = (n0 < FFW) ? n0 : n0 - FFW; const int dn0 = (ch >> 7) * 256 + (ch & 127) + ((n0 < FFW) ? 0 : 128);
          tr_tile(a.in[18], UPN, (bf16*)(ws + WS_WUP), DM, 64 * (r / nb), n0, dn0, scr, lane); continue; } r -= T_UP;
        if (r < T_DN) { const int nb = DM / 64; tr_tile(a.in[21], DM, (bf16*)(ws + WS_WDN), FFW, 64 * (r / nb), 64 * (r % nb), 64 * (r % nb), scr, lane); continue; } r -= T_DN;
        if (r < T_PA) { const int nb = DM / 64; tr_tile(a.in[14], DM, (bf16*)(ws + WS_PA), SGW, 64 * (r / nb), 64 * (r % nb), 64 * (r % nb), scr, lane); continue; } r -= T_PA;
        if (r < T_PB) { const int nb = DM / 64; tr_tile(a.in[15], DM, (bf16*)(ws + WS_PB), LW, 64 * (r / nb), 64 * (r % nb), 64 * (r % nb), scr, lane); continue; } r -= T_PB;
        if (r < T_WO) { const int nb = DM / 64; tr_tile(a.in[16], DM, (bf16*)(ws + WS_WOUT), DM, 64 * (r / nb), 64 * (r % nb), 64 * (r % nb), scr, lane); continue; } r -= T_WO;
        if (r < T_G) { const int hd = r >> 4, t = r & 15; tr_tile(a.in[9] + (size_t)hd * LHD * LHD, LHD, (bf16*)(ws + WS_WA) + (size_t)hd * LHD * LHD, LHD, 64 * (t >> 2), 64 * (t & 3), 64 * (t & 3), scr, lane); continue; } r -= T_G;
        { const int hd = r >> 4, t = r & 15; tr_tile(a.in[11] + (size_t)hd * LHD * LHD, LHD, (bf16*)(ws + WS_WX) + (size_t)hd * LHD * LHD, LHD, 64 * (t >> 2), 64 * (t & 3), 64 * (t & 3), scr, lane); }
    }
    const float* x = a.in[0]; const f32x4* gm = (const f32x4*)a.in[1] + lane; bf16* H = (bf16*)(ws + WS_H);
    for (int m = gw; m < M; m += NGW) {
        const f32x4* xr = (const f32x4*)(x + (size_t)m * DM) + lane; f32x4 v[16]; float s = 0.f;
#pragma unroll
        for (int j = 0; j < 16; ++j) { v[j] = xr[64 * j]; s += (v[j][0] * v[j][0] + v[j][1] * v[j][1]) + (v[j][2] * v[j][2] + v[j][3] * v[j][3]); }
        const float rs = 1.0f / sqrtf(wave_sum(s) * (1.0f / DM) + EPS);
        u32x2* o = (u32x2*)(H + (size_t)m * DM) + lane;
#pragma unroll
        for (int j = 0; j < 16; ++j) { const f32x4 g = gm[64 * j]; u32x2 w; w.x = cvt_pk_bf16(v[j][0] * rs * g[0], v[j][1] * rs * g[1]); w.y = cvt_pk_bf16(v[j][2] * rs * g[2], v[j][3] * rs * g[3]); o[64 * j] = w; }
    }
}

constexpr int MA_PITCH = 272;
constexpr int MA_WT = 0, MA_VN = 128 * MA_PITCH;
__device__ __forceinline__ void mixer_a_unit(const Args& a, LAS unsigned char* lds, int unit) {
    const int tid = opaque_tid(), lane = tid & 63, wave = __builtin_amdgcn_readfirstlane(tid >> 6);
    unsigned char* ws = a.ws;
    const int g = unit & 7, bc = unit >> 3;
    const int R0 = bc * CHUNK, C0 = g * SGD;
    const bf16* GU = (const bf16*)(ws + WS_GU); const bf16* GV = (const bf16*)(ws + WS_GV); bf16* YA = (bf16*)(ws + WS_YA);
    const float* vsum = (const float*)(ws + WS_CTL) + CW_VSUM; const float* vsq = (const float*)(ws + WS_CTL) + CW_VSQ;
    { const int t = tid >> 2, sq = tid & 3; const float* src = a.in[5] + ((size_t)g * CHUNK + t) * CHUNK + 32 * sq;
#pragma unroll
      for (int i = 0; i < 4; ++i) { const f32x4 w0 = *(const f32x4*)(src + 8 * i), w1 = *(const f32x4*)(src + 8 * i + 4); const int s0 = 32 * sq + 8 * i;
          float e[8] = {w0[0], w0[1], w0[2], w0[3], w1[0], w1[1], w1[2], w1[3]};
#pragma unroll
          for (int j = 0; j < 8; ++j) e[j] = (s0 + j <= t) ? e[j] : 0.f;
          u32x4 o; o.x = cvt_pk_bf16(e[0], e[1]); o.y = cvt_pk_bf16(e[2], e[3]); o.z = cvt_pk_bf16(e[4], e[5]); o.w = cvt_pk_bf16(e[6], e[7]);
          *(LAS u32x4*)(lds + MA_WT + t * MA_PITCH + s0 * 2) = o; } }
    { const int s0 = 2 * lane; const int r0 = R0 + s0;
      const float mu0 = vsum[r0] * (1.0f / SGW), mu1 = vsum[r0 + 1] * (1.0f / SGW);
      const float rs0 = 1.0f / sqrtf(fmaxf(vsq[r0] * (1.0f / SGW) - mu0 * mu0, 0.f) + EPS), rs1 = 1.0f / sqrtf(fmaxf(vsq[r0 + 1] * (1.0f / SGW) - mu1 * mu1, 0.f) + EPS);
#pragma unroll
      for (int it = 0; it < 4; ++it) { const int cg = wave * 4 + it; const int col = C0 + 8 * cg;
          const u32x4 q0 = *(const u32x4*)(GV + (size_t)r0 * SGW + col), q1 = *(const u32x4*)(GV + (size_t)(r0 + 1) * SGW + col);
          const f32x4 lg0 = *(const f32x4*)(a.in[3] + col), lg1 = *(const f32x4*)(a.in[3] + col + 4), lb0 = *(const f32x4*)(a.in[4] + col), lb1 = *(const f32x4*)(a.in[4] + col + 4);
          const float x0[8] = {bf_lo(q0.x), bf_hi(q0.x), bf_lo(q0.y), bf_hi(q0.y), bf_lo(q0.z), bf_hi(q0.z), bf_lo(q0.w), bf_hi(q0.w)};
          const float x1[8] = {bf_lo(q1.x), bf_hi(q1.x), bf_lo(q1.y), bf_hi(q1.y), bf_lo(q1.z), bf_hi(q1.z), bf_lo(q1.w), bf_hi(q1.w)};
          const float lg[8] = {lg0[0], lg0[1], lg0[2], lg0[3], lg1[0], lg1[1], lg1[2], lg1[3]}, lb[8] = {lb0[0], lb0[1], lb0[2], lb0[3], lb1[0], lb1[1], lb1[2], lb1[3]};
#pragma unroll
          for (int j = 0; j < 8; ++j) { const float n0 = (x0[j] - mu0) * rs0 * lg[j] + lb[j], n1 = (x1[j] - mu1) * rs1 * lg[j] + lb[j];
              *(LAS unsigned*)(lds + MA_VN + (8 * cg + j) * MA_PITCH + 4 * lane) = cvt_pk_bf16(n0, n1); } } }
    LDS_WAIT(); __syncthreads();
    const int fr = lane & 15, fq = lane >> 4;
    f32x4 acc[8][2];
#pragma unroll
    for (int m = 0; m < 8; ++m) { acc[m][0] = (f32x4){0.f, 0.f, 0.f, 0.f}; acc[m][1] = (f32x4){0.f, 0.f, 0.f, 0.f}; }
#pragma unroll
    for (int ks = 0; ks < 4; ++ks) {
        bf16x8 vf[2];
#pragma unroll
        for (int n = 0; n < 2; ++n) vf[n] = *(const LAS bf16x8*)(lds + MA_VN + (32 * wave + 16 * n + fr) * MA_PITCH + (32 * ks + 8 * fq) * 2);
#pragma unroll
        for (int m = 0; m < 8; ++m) { if (32 * ks > 16 * m + 15) continue;
            const bf16x8 wf = *(const LAS bf16x8*)(lds + MA_WT + (16 * m + fr) * MA_PITCH + (32 * ks + 8 * fq) * 2);
#pragma unroll
            for (int n = 0; n < 2; ++n) acc[m][n] = __builtin_amdgcn_mfma_f32_16x16x32_bf16(vf[n], wf, acc[m][n], 0, 0, 0); }
    }
#pragma unroll
    for (int m = 0; m < 8; ++m) { const int t = 16 * m + fr; const float bs = a.in[6][g * CHUNK + t];
#pragma unroll
        for (int n = 0; n < 2; ++n) { const size_t off = (size_t)(R0 + t) * SGW + C0 + 32 * wave + 16 * n + 4 * fq; const u32x2 gu = *(const u32x2*)(GU + off);
            u32x2 o; o.x = cvt_pk_bf16(bf_lo(gu.x) * (acc[m][n][0] + bs), bf_hi(gu.x) * (acc[m][n][1] + bs)); o.y = cvt_pk_bf16(bf_lo(gu.y) * (acc[m][n][2] + bs), bf_hi(gu.y) * (acc[m][n][3] + bs));
            *(u32x2*)(YA + off) = o; } }
    __syncthreads();
}

constexpr int MB_XPITCH = 528;
constexpr int MB_XC = 0, MB_AG = 128 * MB_XPITCH  , MB_CTAB = MB_AG + 128 * 65 * 8  ;
static_assert(MB_CTAB + 5 * 256 * 4 <= MISC_OFF, "mixer B LDS map");
typedef float f32x2 __attribute__((ext_vector_type(2)));
__device__ __forceinline__ void mixer_b_unit(const Args& a, LAS unsigned char* lds, int unit) {
    const int tid = opaque_tid(), lane = tid & 63, wave = __builtin_amdgcn_readfirstlane(tid >> 6);
    unsigned char* ws = a.ws;
    const int q = unit & 3, hd = (unit >> 2) & 15, b = unit >> 6;
    const int HC = hd * LHD, OC = HC + 64 * q;
    const bf16* XR = (const bf16*)(ws + WS_XR); const bf16* GYR = (const bf16*)(ws + WS_GYR); bf16* YB = (bf16*)(ws + WS_YB);
    const bf16* WaT = (const bf16*)(ws + WS_WA) + (size_t)hd * LHD * LHD; const bf16* WxT = (const bf16*)(ws + WS_WX) + (size_t)hd * LHD * LHD;
    const int fr = lane & 15, fq = lane >> 4, cb = wave & 3, rh = wave >> 2;
    bf16x8 bfa[8], bfx[8];
#pragma unroll
    for (int ks = 0; ks < 8; ++ks) { const size_t o = (size_t)(64 * q + 16 * cb + fr) * LHD + 32 * ks + 8 * fq; bfa[ks] = *(const bf16x8*)(WaT + o); bfx[ks] = *(const bf16x8*)(WxT + o); }
    float ba[4], bx[4], sp[4];
#pragma unroll
    for (int e = 0; e < 4; ++e) { const int col = OC + 16 * cb + 4 * fq + e; ba[e] = a.in[10][col]; bx[e] = a.in[12][col]; sp[e] = -8.0f * log1pf(expf(-a.in[13][col])); }
    const int cg = tid & 31, rg = tid >> 5;
    LAS float* ctab = (LAS float*)(lds + MB_CTAB);
    for (int i = tid; i < 5 * LHD; i += NWAVES * 64) { const int k = i >> 8, c = i & 255; ctab[i] = (k < 4) ? a.in[7][(size_t)k * LW + HC + c] : a.in[8][HC + c]; }
    LAS f32x2* ag = (LAS f32x2*)(lds + MB_AG);
    const int c8 = lane & 7, rgp = lane >> 3;
    float carry = 0.f;
    const bf16* xrp = XR + ((size_t)b * SEQ + 8 * rg) * LW + HC + 8 * cg;
    u32x4 raw[11];
#pragma unroll
    for (int i = 0; i < 11; ++i) raw[i] = (8 * rg - 3 + i >= 0) ? *(const u32x4*)(xrp + (ptrdiff_t)(i - 3) * LW) : (u32x4){0u, 0u, 0u, 0u};
    LDS_WAIT(); __syncthreads();
    for (int step = 0; step < SEQ / 128; ++step) {
        const int t0 = step * 128; const size_t rowbase = (size_t)b * SEQ + t0;
        { f32x4 cw[5][2];
#pragma unroll
          for (int k = 0; k < 5; ++k) { cw[k][0] = *(const LAS f32x4*)(ctab + k * LHD + 8 * cg); cw[k][1] = *(const LAS f32x4*)(ctab + k * LHD + 8 * cg + 4); }
#pragma unroll
          for (int r = 0; r < 8; ++r) { float o[8];
#pragma unroll
              for (int j = 0; j < 8; ++j) o[j] = cw[4][j >> 2][j & 3];
#pragma unroll
              for (int k = 0; k < 4; ++k) { const u32x4 w = raw[r + k];
                  o[0] += cw[k][0][0] * bf_lo(w.x); o[1] += cw[k][0][1] * bf_hi(w.x); o[2] += cw[k][0][2] * bf_lo(w.y); o[3] += cw[k][0][3] * bf_hi(w.y);
                  o[4] += cw[k][1][0] * bf_lo(w.z); o[5] += cw[k][1][1] * bf_hi(w.z); o[6] += cw[k][1][2] * bf_lo(w.w); o[7] += cw[k][1][3] * bf_hi(w.w); }
              u32x4 p; p.x = cvt_pk_bf16(o[0], o[1]); p.y = cvt_pk_bf16(o[2], o[3]); p.z = cvt_pk_bf16(o[4], o[5]); p.w = cvt_pk_bf16(o[6], o[7]);
              *(LAS u32x4*)(lds + MB_XC + (8 * rg + r) * MB_XPITCH + 16 * cg) = p; } }
        if (step + 1 < SEQ / 128) {
#pragma unroll
            for (int i = 0; i < 11; ++i) raw[i] = *(const u32x4*)(xrp + (ptrdiff_t)(t0 + 128 + i - 3) * LW); }
        const size_t gb = (rowbase + 16 * rgp) * LW + OC + 8 * wave + c8;
        unsigned short yr[16];
#pragma unroll
        for (int i = 0; i < 16; ++i) yr[i] = GYR[gb + (size_t)i * LW];
        LDS_BARRIER();
        { f32x4 ca[4], cx[4];
#pragma unroll
          for (int m = 0; m < 4; ++m) { ca[m] = (f32x4){0.f, 0.f, 0.f, 0.f}; cx[m] = (f32x4){0.f, 0.f, 0.f, 0.f}; }
#pragma unroll
          for (int ks = 0; ks < 8; ++ks)
#pragma unroll
              for (int m = 0; m < 4; ++m) { const bf16x8 af = *(const LAS bf16x8*)(lds + MB_XC + (64 * rh + 16 * m + fr) * MB_XPITCH + (32 * ks + 8 * fq) * 2);
                  ca[m] = __builtin_amdgcn_mfma_f32_16x16x32_bf16(bfa[ks], af, ca[m], 0, 0, 0); cx[m] = __builtin_amdgcn_mfma_f32_16x16x32_bf16(bfx[ks], af, cx[m], 0, 0, 0); }
#pragma unroll
          for (int m = 0; m < 4; ++m) { const int r = 64 * rh + 16 * m + fr; const int cl = 16 * cb + 4 * fq;
              const u32x2 xw = *(const LAS u32x2*)(lds + MB_XC + r * MB_XPITCH + (64 * q + cl) * 2);
              const float xv[4] = {bf_lo(xw.x), bf_hi(xw.x), bf_lo(xw.y), bf_hi(xw.y)};
#pragma unroll
              for (int e = 0; e < 4; ++e) { const float rgt = sigmoid_f(ca[m][e] + ba[e]), ig = sigmoid_f(cx[m][e] + bx[e]);
                  const float la = rgt * sp[e]; const float av = __builtin_amdgcn_exp2f(1.4426950409f * la);
                  const float y = 2.0f * la;
                  const float om = (y > -0.0625f) ? -y * (1.0f + y * (0.5f + y * (0.16666667f + y * 0.041666668f))) : (1.0f - av * av);
                  ag[r * 65 + cl + e] = (f32x2){av, __builtin_amdgcn_sqrtf(om) * ig * xv[e]}; } } }
        LDS_BARRIER();
        { f32x2 v[16]; float P = 1.f, Hh = 0.f;
#pragma unroll
          for (int i = 0; i < 16; ++i) { v[i] = ag[(16 * rgp + i) * 65 + 8 * wave + c8]; Hh = v[i].x * Hh + v[i].y; P *= v[i].x; }
#pragma unroll
          for (int d = 8; d < 64; d <<= 1) { const float Pp = __shfl_up(P, d), Hp = __shfl_up(Hh, d); if (lane >= d) { Hh = P * Hp + Hh; P = P * Pp; } }
          const float Pe = __shfl_up(P, 8), He = __shfl_up(Hh, 8);
          float c = (rgp == 0) ? carry : (Pe * carry + He);
          const float Pt = __shfl(P, 56 + c8), Ht = __shfl(Hh, 56 + c8);
          carry = Pt * carry + Ht;
#pragma unroll
          for (int i = 0; i < 16; ++i) { c = v[i].x * c + v[i].y; const float y = c * __uint_as_float((unsigned)yr[i] << 16); YB[gb + (size_t)i * LW] = (bf16)(cvt_pk_bf16(y, 0.f) & 0xffffu); } }
    }
    __syncthreads();
}

__device__ __forceinline__ void p6_fixup(const Args& a, int vcu, int G) {
    const int gt = vcu * (NWAVES * 64) + opaque_tid(), NT = G * NWAVES * 64;
    unsigned char* ws = a.ws; const float* HEAD = (const float*)(ws + WS_HEAD); const float* TAIL = (const float*)(ws + WS_TAIL); bf16* Gb = (bf16*)(ws + WS_G);
    const float* cw = a.in[19]; const float* cbv = a.in[20];
    for (int item = gt; item < 32 * 96 * 128; item += NT) {
        const int jj = item & 127, t = item >> 7, pn = t % 96, pm = t / 96; const int c = 128 * pn + jj;
        const float* hb = HEAD + ((size_t)(pm * 96 + pn) * 2) * 256;
        const float h0g = hb[jj], h1g = hb[256 + jj], h0v = hb[128 + jj], h1v = hb[256 + 128 + jj];
        float t0g = 0.f, t1g = 0.f, t0v = 0.f, t1v = 0.f;
        if (pm & 7) { const float* tb = TAIL + ((size_t)((pm - 1) * 96 + pn) * 2) * 256; t0g = tb[jj]; t1g = tb[256 + jj]; t0v = tb[128 + jj]; t1v = tb[256 + 128 + jj]; }
        const float wg0 = cw[c], wg1 = cw[UPN + c], wg2 = cw[2 * UPN + c], wv0 = cw[FFW + c], wv1 = cw[UPN + FFW + c], wv2 = cw[2 * UPN + FFW + c], bg = cbv[c], bv = cbv[FFW + c];
        const float g0 = bg + wg0 * t0g + wg1 * t1g + wg2 * h0g, v0 = bv + wv0 * t0v + wv1 * t1v + wv2 * h0v;
        const float g1 = bg + wg0 * t1g + wg1 * h0g + wg2 * h1g, v1 = bv + wv0 * t1v + wv1 * h0v + wv2 * h1v;
        Gb[(size_t)(256 * pm) * FFW + c] = (bf16)(cvt_pk_bf16(gelu_tanh_f(g0) * v0, 0.f) & 0xffffu);
        Gb[(size_t)(256 * pm + 1) * FFW + c] = (bf16)(cvt_pk_bf16(gelu_tanh_f(g1) * v1, 0.f) & 0xffffu);
    }
}

__device__ __forceinline__ void p8_final(const Args& a, int vcu, int G) {
    const int tid = opaque_tid(), lane = tid & 63, gw = vcu * NWAVES + __builtin_amdgcn_readfirstlane(tid >> 6), NGW = G * NWAVES;
    const float* rss = (const float*)(a.ws + WS_CTL) + CW_RSS3; const f32x4* gf = (const f32x4*)a.in[22] + lane;
    for (int m = gw; m < M; m += NGW) { const float rs = 1.0f / sqrtf(rss[m] * (1.0f / DM) + EPS); f32x4* o = (f32x4*)(a.out + (size_t)m * DM) + lane;
#pragma unroll
        for (int j = 0; j < 16; ++j) { const f32x4 v = o[64 * j], g = gf[64 * j]; o[64 * j] = v * rs * g; } }
}

__global__ void __launch_bounds__(NWAVES * 64, 2) hyb_fwd(Args args) {
    extern __shared__ __attribute__((aligned(16))) unsigned char lds_raw[];
    LAS unsigned char* lds = (LAS unsigned char*)lds_raw;
    volatile LAS unsigned* MISC = (volatile LAS unsigned*)(lds + MISC_OFF);
    const int tid = threadIdx.x;
    const int G = gridDim.x; const int bx = blockIdx.x; const int vcu = (G % 8 == 0) ? (bx % 8) * (G / 8) + bx / 8 : bx;
    unsigned char* ws = args.ws;
    unsigned* ctl = (unsigned*)(ws + WS_CTL);
    for (int u = tid; u < (LDS_BYTES - MISC_OFF) / 4; u += NWAVES * 64) ((LAS unsigned*)(lds + MISC_OFF))[u] = 0u;
    __syncthreads();
    XcdBarrier bar; bar.bar = ctl + CW_BAR; bar.x = 0; bar.st = nullptr;
    if (N_LAUNCHES == 1) bar = xcd_barrier_post(ctl + CW_BAR, MISC + 8);
#define GRID_BAR() do { if (N_LAUNCHES == 1) xcd_barrier(bar); } while (0)
    const int lo = args.ph_lo, hi = args.ph_hi;
#ifndef PH_MASK
#define PH_MASK 0x1ff
#endif
#ifndef REP_PH
#define REP_PH -1
#endif
#define NREP(k) ((REP_PH == (k)) ? 2 : 1)
#define IN(k) (((PH_MASK >> (k)) & 1) && lo <= (k) && (k) < hi)
#define BOTH(k) (IN(k) && IN((k) + 1))
    float* fctl = (float*)ctl;

    if (IN(0)) { for (int rep = 0; rep < NREP(0); ++rep) p0_prologue(args, lds, vcu, G); if (BOTH(0)) GRID_BAR(); }

    if (IN(1)) {
        pg8::Gemm g{(const bf16*)(ws + WS_H), (const bf16*)(ws + WS_WIN), M, INC, DM}; pg8::StaticOrder S; S.init(M, INC, G, bx);
        pg8::EpiProj E{(bf16*)(ws + WS_GU), (bf16*)(ws + WS_GV), (bf16*)(ws + WS_XR), (bf16*)(ws + WS_GYR), (bf16*)(ws + WS_SGA), (bf16*)(ws + WS_SGB), fctl + CW_VSUM, fctl + CW_VSQ};
        pg8::gemm_phase<pg8::EpiProj, pg8::StaticOrder, PG8_ALIGN, PG8_SP2>(lds, g, S, E);
        if (NREP(1) == 2) { pg8::EpiProj E2 = E; E2.vsum = fctl + CW_DUMMY; E2.vsq = fctl + CW_DUMMY + M; pg8::gemm_phase<pg8::EpiProj, pg8::StaticOrder, PG8_ALIGN, PG8_SP2>(lds, g, S, E2); }
        if (BOTH(1)) GRID_BAR();
    }

    if (IN(2)) {
        for (int rep = 0; rep < NREP(20); ++rep) for (int u = bx; u < NB * LH * 4; u += G) mixer_b_unit(args, lds, u);
        for (int rep = 0; rep < NREP(21); ++rep) for (int u = bx; u < NB * (SEQ / CHUNK) * 8; u += G) mixer_a_unit(args, lds, u);
        if (BOTH(2)) GRID_BAR();
    }

    if (IN(3)) {
        { pg8::Gemm g{(const bf16*)(ws + WS_YA), (const bf16*)(ws + WS_PA), M, DM, SGW}; pg8::StaticOrder S; S.init(M, DM, G, bx);
          pg8::EpiPA E{(const bf16*)(ws + WS_SGA), (float*)(ws + WS_M1)};
          pg8::gemm_phase<pg8::EpiPA, pg8::StaticOrder, PG8_ALIGN, PG8_SP2>(lds, g, S, E); }
        { pg8::Gemm g{(const bf16*)(ws + WS_YB), (const bf16*)(ws + WS_PB), M, DM, LW}; pg8::StaticOrder S; S.init(M, DM, G, bx);
          pg8::EpiPB E{(const bf16*)(ws + WS_SGB), (const float*)(ws + WS_M1), (bf16*)(ws + WS_MRG)};
          pg8::gemm_phase<pg8::EpiPB, pg8::StaticOrder, PG8_ALIGN, PG8_SP2>(lds, g, S, E); }
        if (NREP(3) == 2) {
        { pg8::Gemm g{(const bf16*)(ws + WS_YA), (const bf16*)(ws + WS_PA), M, DM, SGW}; pg8::StaticOrder S; S.init(M, DM, G, bx);
          pg8::EpiPA E{(const bf16*)(ws + WS_SGA), (float*)(ws + WS_M1)};
          pg8::gemm_phase<pg8::EpiPA, pg8::StaticOrder, PG8_ALIGN, PG8_SP2>(lds, g, S, E); }
        { pg8::Gemm g{(const bf16*)(ws + WS_YB), (const bf16*)(ws + WS_PB), M, DM, LW}; pg8::StaticOrder S; S.init(M, DM, G, bx);
          pg8::EpiPB E{(const bf16*)(ws + WS_SGB), (const float*)(ws + WS_M1), (bf16*)(ws + WS_MRG)};
          pg8::gemm_phase<pg8::EpiPB, pg8::StaticOrder, PG8_ALIGN, PG8_SP2>(lds, g, S, E); }
        }
        if (BOTH(3)) GRID_BAR();
    }

    if (IN(4)) {
        pg8::Gemm g{(const bf16*)(ws + WS_MRG), (const bf16*)(ws + WS_WOUT), M, DM, DM}; pg8::StaticOrder S; S.init(M, DM, G, bx);
        pg8::EpiResid<true> E{args.in[0], (float*)(ws + WS_X1), (bf16*)(ws + WS_X1B), args.in[17], fctl + CW_RSS2};
        pg8::gemm_phase<pg8::EpiResid<true>, pg8::StaticOrder, PG8_ALIGN, PG8_SP2>(lds, g, S, E);
        if (NREP(4) == 2) { pg8::EpiResid<true> E2 = E; E2.rowss = fctl + CW_DUMMY; pg8::gemm_phase<pg8::EpiResid<true>, pg8::StaticOrder, PG8_ALIGN, PG8_SP2>(lds, g, S, E2); }
        if (BOTH(4)) GRID_BAR();
    }

    if (IN(5)) {
        pg8::Gemm g{(const bf16*)(ws + WS_X1B), (const bf16*)(ws + WS_WUP), M, UPN, DM}; pg8::StaticOrder S; S.init(M, UPN, G, bx);
        pg8::EpiUpGate E{(bf16*)(ws + WS_G), fctl + CW_RSS2, args.in[19], args.in[20], (float*)(ws + WS_HEAD), (float*)(ws + WS_TAIL), (LAS float*)(lds + HALO_OFF)};
        pg8::gemm_phase<pg8::EpiUpGate, pg8::StaticOrder, PG8_ALIGN, PG8_SP2>(lds, g, S, E);
        if (NREP(5) == 2) pg8::gemm_phase<pg8::EpiUpGate, pg8::StaticOrder, PG8_ALIGN, PG8_SP2>(lds, g, S, E);
        if (BOTH(5)) GRID_BAR();
    }

    if (IN(6)) { for (int rep = 0; rep < NREP(6); ++rep) p6_fixup(args, vcu, G); if (BOTH(6)) GRID_BAR(); }

    if (IN(7)) {
        pg8::Gemm g{(const bf16*)(ws + WS_G), (const bf16*)(ws + WS_WDN), M, DM, FFW}; pg8::StaticOrder S; S.init(M, DM, G, bx);
        pg8::EpiResid<false> E{(const float*)(ws + WS_X1), args.out, nullptr, nullptr, fctl + CW_RSS3};
        pg8::gemm_phase<pg8::EpiResid<false>, pg8::StaticOrder, PG8_ALIGN, PG8_SP2>(lds, g, S, E);
        if (NREP(7) == 2) { pg8::EpiResid<false> E2 = E; E2.rowss = fctl + CW_DUMMY; pg8::gemm_phase<pg8::EpiResid<false>, pg8::StaticOrder, PG8_ALIGN, PG8_SP2>(lds, g, S, E2); }
        if (BOTH(7)) GRID_BAR();
    }

    if (IN(8)) p8_final(args, vcu, G);
#undef IN
#undef BOTH
#undef GRID_BAR
}

extern "C" void kernel_launch(void* const* d_in, const int* in_sizes, int n_in, void* d_out, int out_size, void* d_ws, size_t ws_size, hipStream_t stream) {
    static int grid = 0;
    if (grid == 0) {
        if (n_in != 23 || out_size != M * DM || ws_size < WS_END) { fprintf(stderr, "kernel_launch: unexpected shapes (n_in %d, out %d, ws %zu)\n", n_in, out_size, ws_size); grid = -1; return; }
        int dev = 0, cus = 0, per_cu = 0;
        if (hipGetDevice(&dev) != hipSuccess || hipDeviceGetAttribute(&cus, hipDeviceAttributeMultiprocessorCount, dev) != hipSuccess) { grid = -1; return; }
        if (hipFuncSetAttribute((const void*)hyb_fwd, hipFuncAttributeMaxDynamicSharedMemorySize, LDS_BYTES) != hipSuccess) { fprintf(stderr, "kernel_launch: hipFuncSetAttribute failed\n"); grid = -1; return; }
        if (hipOccupancyMaxActiveBlocksPerMultiprocessor(&per_cu, (const void*)hyb_fwd, NWAVES * 64, LDS_BYTES) != hipSuccess || per_cu < 1) { fprintf(stderr, "kernel_launch: occupancy query says %d\n", per_cu); }
        (void)hipGetLastError();
        grid = cus;
    }
    if (grid < 0) return;
    (void)in_sizes;
    (void)hipMemsetAsync((char*)d_ws + WS_CTL, 0, CTL_ZERO_BYTES, stream);
    Args a{};
    for (int i = 0; i < 23; ++i) a.in[i] = (const float*)d_in[i];
    a.out = (float*)d_out; a.ws = (unsigned char*)d_ws;
    if (N_LAUNCHES == 1) { a.ph_lo = 0; a.ph_hi = NPH; hipLaunchKernelGGL(hyb_fwd, dim3(grid), dim3(NWAVES * 64), LDS_BYTES, stream, a); }
    else for (int p = 0; p < NPH; ++p) { a.ph_lo = p; a.ph_hi = p + 1; hipLaunchKernelGGL(hyb_fwd, dim3(grid), dim3(NWAVES * 64), LDS_BYTES, stream, a); }
}
```

```cpp
#include <hip/hip_runtime.h>
#include <cstdio>
#include <cstdint>

#ifndef MK_N_LAUNCHES
#define MK_N_LAUNCHES 1
#endif

namespace pg8 {
#define PG8_LAS __attribute__((address_space(3)))
typedef unsigned short bf16_t;
typedef short bf16x8 __attribute__((ext_vector_type(8)));
typedef float f32x4 __attribute__((ext_vector_type(4)));
typedef unsigned u32x4 __attribute__((ext_vector_type(4)));
typedef unsigned u32x2 __attribute__((ext_vector_type(2)));
constexpr int BM = 256, BK = 64, HALF = 128, HTB = HALF * BK * 2  , STAGE_BYTES = 8 * HTB, NXCD = 8, WGM = 8;

__host__ __device__ __forceinline__ int lds_byte(int r, int c) { const int st = (r >> 4) * 2 + (c >> 5), rr = r & 15, cc = c & 31, ob = rr * 64 + cc * 2; return st * 1024 + (ob ^ (((ob >> 9) & 1) << 5)); }
__host__ __device__ __forceinline__ void stage_rc(int b, int& R, int& C) { const int st = b / 1024, sb = b % 1024, swz = sb ^ (((sb >> 9) & 1) << 5); R = (st >> 1) * 16 + swz / 64; C = (st & 1) * 32 + (swz % 64) / 2; }
__host__ __device__ __forceinline__ int perm32(int rho) { const int n = rho >> 4, i = rho & 15; return 8 * (i >> 2) + 4 * n + (i & 3); }

struct Unit { int pm, pn; };
struct Gemm { const bf16_t* A; const bf16_t* Bt; int M, N, K; };

struct StaticOrder {
    int nM, nN, nwg, G, c;
    __host__ __device__ void init(int M, int N, int G_, int c_) { nM = M / BM; nN = N / BM; nwg = nM * nN; G = G_; c = c_; }
    __host__ __device__ bool next(int i, Unit& u) const {
        const long L = (long)i * G + c; if (L >= nwg) return false;
        int wgid = (int)L; { const int q = nwg / NXCD, r = nwg % NXCD, xcd = wgid % NXCD, off = wgid / NXCD; wgid = (xcd < r ? xcd * (q + 1) : r * (q + 1) + (xcd - r) * q) + off; }
        const int nig = WGM * nN, gid = wgid / nig, fm = gid * WGM, gsz = (nM - fm) < WGM ? (nM - fm) : WGM;
        u.pm = fm + ((wgid % nig) % gsz); u.pn = (wgid % nig) / gsz; return true;
    }
    __device__ __forceinline__ void a_ready(const Unit&) const {}
    __device__ __forceinline__ void done(const Unit&) const {}
};

__device__ __forceinline__ unsigned cvt_pk_bf16(float lo, float hi) { unsigned r; asm volatile("v_cvt_pk_bf16_f32 %0, %1, %2" : "=v"(r) : "v"(lo), "v"(hi)); return r; }
__device__ __forceinline__ float bf_lo(unsigned w) { return __uint_as_float(w << 16); }
__device__ __forceinline__ float bf_hi(unsigned w) { return __uint_as_float(w & 0xffff0000u); }
__device__ __forceinline__ float sigmoid_f(float z) { return __builtin_amdgcn_rcpf(1.0f + __builtin_amdgcn_exp2f(-1.4426950409f * z)); }
__device__ __forceinline__ float gelu_tanh_f(float v) { const float z = 1.5957691216f * (v + 0.044715f * v * v * v); return v * sigmoid_f(z); }


struct EpiProj {
    static constexpr bool PERM = true, AFTER_DRAIN = false, PERMA = false;
    bf16_t *GU, *GV, *XR, *GYR, *SGA, *SGB; float *vsum, *vsq;
    __device__ __forceinline__ void operator()(const f32x4 (&acc)[2][2][4][2], const Unit& u, int wr, int wc, int fr, int fq) const {
        const int pn = u.pn; bf16_t* base; int ldc, colt, act;
        if (pn < 8)       { base = GU;  ldc = 2048; colt = pn * 256;        act = 1; }
        else if (pn < 16) { base = GV;  ldc = 2048; colt = (pn - 8) * 256;  act = 1; }
        else if (pn < 32) { base = XR;  ldc = 4096; colt = (pn - 16) * 256; act = 0; }
        else if (pn < 48) { base = GYR; ldc = 4096; colt = (pn - 32) * 256; act = 1; }
        else if (pn < 64) { base = SGA; ldc = 4096; colt = (pn - 48) * 256; act = 2; }
        else              { base = SGB; ldc = 4096; colt = (pn - 64) * 256; act = 2; }
        const bool st = (pn >= 8) && (pn < 16);
        const int row0 = u.pm * BM + wr * 64 + fr, col0 = colt + wc * 32 + 8 * fq;
#pragma unroll
        for (int ai = 0; ai < 2; ++ai)
#pragma unroll
            for (int m = 0; m < 4; ++m) { const int row = row0 + ai * HALF + m * 16; bf16_t* rowp = base + (size_t)row * ldc + col0; float s = 0.f, q = 0.f;
#pragma unroll
                for (int bj = 0; bj < 2; ++bj) { f32x4 v0 = acc[ai][bj][m][0], v1 = acc[ai][bj][m][1];
                    if (act == 1) {
#pragma unroll
                        for (int j = 0; j < 4; ++j) { v0[j] = gelu_tanh_f(v0[j]); v1[j] = gelu_tanh_f(v1[j]); } }
                    else if (act == 2) {
#pragma unroll
                        for (int j = 0; j < 4; ++j) { v0[j] = sigmoid_f(v0[j]); v1[j] = sigmoid_f(v1[j]); } }
                    if (st) {
#pragma unroll
                        for (int j = 0; j < 4; ++j) { s += v0[j] + v1[j]; q += v0[j] * v0[j] + v1[j] * v1[j]; } }
                    u32x4 w; w.x = cvt_pk_bf16(v0[0], v0[1]); w.y = cvt_pk_bf16(v0[2], v0[3]); w.z = cvt_pk_bf16(v1[0], v1[1]); w.w = cvt_pk_bf16(v1[2], v1[3]);
                    *(u32x4*)(rowp + bj * HALF) = w; }
                if (st) { s += __shfl_xor(s, 16); s += __shfl_xor(s, 32); q += __shfl_xor(q, 16); q += __shfl_xor(q, 32);
                    if (fq == 0) { unsafeAtomicAdd(vsum + row, s); unsafeAtomicAdd(vsq + row, q); } } }
    }
};
struct EpiMerge {
    static constexpr bool PERM = true, AFTER_DRAIN = false, PERMA = false;
    const bf16_t* SGA; const bf16_t* SGB; bf16_t* O;
    __device__ __forceinline__ void mid(f32x4 (&acc)[2][2][4][2], const Unit& u, int wr, int wc, int fr, int fq) const {
        asm volatile("" : "+v"(fr), "+v"(fq));
        const int row0 = u.pm * BM + wr * 64 + fr, col0 = u.pn * BM + wc * 32 + 8 * fq;
#pragma unroll
        for (int ai = 0; ai < 2; ++ai)
#pragma unroll
            for (int m = 0; m < 4; ++m) { const size_t off = (size_t)(row0 + ai * HALF + m * 16) * 4096 + col0;
#pragma unroll
                for (int bj = 0; bj < 2; ++bj) { const u32x4 ga = *(const u32x4*)(SGA + off + bj * HALF), gb = *(const u32x4*)(SGB + off + bj * HALF);
                    const unsigned wa[4] = {ga.x, ga.y, ga.z, ga.w}, wb[4] = {gb.x, gb.y, gb.z, gb.w};
#pragma unroll
                    for (int p = 0; p < 4; ++p) { const float rl = bf_lo(wa[p]) * __builtin_amdgcn_rcpf(fmaxf(bf_lo(wb[p]), 1e-20f)), rh = bf_hi(wa[p]) * __builtin_amdgcn_rcpf(fmaxf(bf_hi(wb[p]), 1e-20f));
                        acc[ai][bj][m][p >> 1][(p & 1) * 2] *= rl; acc[ai][bj][m][p >> 1][(p & 1) * 2 + 1] *= rh; } }
                if (m == 3) asm volatile("" : "+v"(acc[ai][0][0][0]), "+v"(acc[ai][0][0][1]), "+v"(acc[ai][1][0][0]), "+v"(acc[ai][1][0][1]), "+v"(acc[ai][0][1][0]), "+v"(acc[ai][0][1][1]), "+v"(acc[ai][1][1][0]), "+v"(acc[ai][1][1][1]), "+v"(acc[ai][0][2][0]), "+v"(acc[ai][0][2][1]), "+v"(acc[ai][1][2][0]), "+v"(acc[ai][1][2][1]), "+v"(acc[ai][0][3][0]), "+v"(acc[ai][0][3][1]), "+v"(acc[ai][1][3][0]), "+v"(acc[ai][1][3][1]) :: "memory"); }
    }
    __device__ __forceinline__ void operator()(const f32x4 (&acc)[2][2][4][2], const Unit& u, int wr, int wc, int fr, int fq) const {
        const int row0 = u.pm * BM + wr * 64 + fr, col0 = u.pn * BM + wc * 32 + 8 * fq;
        const bf16_t* gp = SGB + (size_t)row0 * 4096 + col0;
        u32x4 gin[3][2];
#define EPI_LOAD(g) do { const bf16_t* p_ = gp + (size_t)(((g) >> 2) * HALF + ((g) & 3) * 16) * 4096; gin[(g) % 3][0] = *(const u32x4*)(p_); gin[(g) % 3][1] = *(const u32x4*)(p_ + HALF); } while (0)
        EPI_LOAD(0); EPI_LOAD(1);
#pragma unroll
        for (int gi = 0; gi < 8; ++gi) { const int ai = gi >> 2, m = gi & 3;
            if (gi + 2 < 8) EPI_LOAD(gi + 2);
            const size_t off = (size_t)(row0 + ai * HALF + m * 16) * 4096 + col0;
#pragma unroll
            for (int bj = 0; bj < 2; ++bj) { const u32x4 g = gin[gi % 3][bj]; const f32x4 a0 = acc[ai][bj][m][0], a1 = acc[ai][bj][m][1];
                u32x4 w; w.x = cvt_pk_bf16(a0[0] * fmaxf(bf_lo(g.x), 1e-20f), a0[1] * fmaxf(bf_hi(g.x), 1e-20f)); w.y = cvt_pk_bf16(a0[2] * fmaxf(bf_lo(g.y), 1e-20f), a0[3] * fmaxf(bf_hi(g.y), 1e-20f));
                w.z = cvt_pk_bf16(a1[0] * fmaxf(bf_lo(g.z), 1e-20f), a1[1] * fmaxf(bf_hi(g.z), 1e-20f)); w.w = cvt_pk_bf16(a1[2] * fmaxf(bf_lo(g.w), 1e-20f), a1[3] * fmaxf(bf_hi(g.w), 1e-20f));
                *(u32x4*)(O + off + bj * HALF) = w; } }
#undef EPI_LOAD
    }
};
struct EpiOut {
    static constexpr bool PERM = true, AFTER_DRAIN = false, PERMA = false;
    const float* XI; bf16_t* XB; float* rowss;
    __device__ __forceinline__ void operator()(const f32x4 (&acc)[2][2][4][2], const Unit& u, int wr, int wc, int fr, int fq) const {
        const int row0 = u.pm * BM + wr * 64 + fr, col0 = u.pn * BM + wc * 32 + 8 * fq;
        const float* xp = XI + (size_t)row0 * 4096 + col0;
        f32x4 xin[3][4];
#define EPI_LOAD(g) do { const float* p_ = xp + (size_t)(((g) >> 2) * HALF + ((g) & 3) * 16) * 4096; \
            xin[(g) % 3][0] = *(const f32x4*)(p_); xin[(g) % 3][1] = *(const f32x4*)(p_ + 4); xin[(g) % 3][2] = *(const f32x4*)(p_ + HALF); xin[(g) % 3][3] = *(const f32x4*)(p_ + HALF + 4); } while (0)
        EPI_LOAD(0); EPI_LOAD(1);
#pragma unroll
        for (int g = 0; g < 8; ++g) { const int ai = g >> 2, m = g & 3;
            if (g + 2 < 8) EPI_LOAD(g + 2);
            const int row = row0 + ai * HALF + m * 16; const size_t off = (size_t)row * 4096 + col0; float q = 0.f;
#pragma unroll
            for (int bj = 0; bj < 2; ++bj) { const f32x4 x0 = xin[g % 3][2 * bj] + acc[ai][bj][m][0], x1 = xin[g % 3][2 * bj + 1] + acc[ai][bj][m][1];
#pragma unroll
                for (int j = 0; j < 4; ++j) q += x0[j] * x0[j] + x1[j] * x1[j];
                u32x4 w; w.x = cvt_pk_bf16(x0[0], x0[1]); w.y = cvt_pk_bf16(x0[2], x0[3]); w.z = cvt_pk_bf16(x1[0], x1[1]); w.w = cvt_pk_bf16(x1[2], x1[3]);
                *(u32x4*)(XB + off + bj * HALF) = w; }
            q += __shfl_xor(q, 16); q += __shfl_xor(q, 32);
            if (fq == 0) unsafeAtomicAdd(rowss + row, q); }
#undef EPI_LOAD
    }
};
struct EpiDown {
    static constexpr bool PERM = true, AFTER_DRAIN = false, PERMA = false;
    const bf16_t* XI; float* XO; float* rowss;
    __device__ __forceinline__ void operator()(const f32x4 (&acc)[2][2][4][2], const Unit& u, int wr, int wc, int fr, int fq) const {
        const int row0 = u.pm * BM + wr * 64 + fr, col0 = u.pn * BM + wc * 32 + 8 * fq;
        const bf16_t* xp = XI + (size_t)row0 * 4096 + col0;
        u32x4 xin[3][2];
#define EPI_LOAD(g) do { const bf16_t* p_ = xp + (size_t)(((g) >> 2) * HALF + ((g) & 3) * 16) * 4096; xin[(g) % 3][0] = *(const u32x4*)(p_); xin[(g) % 3][1] = *(const u32x4*)(p_ + HALF); } while (0)
        EPI_LOAD(0); EPI_LOAD(1);
#pragma unroll
        for (int g = 0; g < 8; ++g) { const int ai = g >> 2, m = g & 3;
            if (g + 2 < 8) EPI_LOAD(g + 2);
            const int row = row0 + ai * HALF + m * 16; const size_t off = (size_t)row * 4096 + col0; float q = 0.f;
#pragma unroll
            for (int bj = 0; bj < 2; ++bj) { const u32x4 r = xin[g % 3][bj]; const f32x4 a0 = acc[ai][bj][m][0], a1 = acc[ai][bj][m][1];
                f32x4 x0, x1; x0[0] = bf_lo(r.x) + a0[0]; x0[1] = bf_hi(r.x) + a0[1]; x0[2] = bf_lo(r.y) + a0[2]; x0[3] = bf_hi(r.y) + a0[3];
                x1[0] = bf_lo(r.z) + a1[0]; x1[1] = bf_hi(r.z) + a1[1]; x1[2] = bf_lo(r.w) + a1[2]; x1[3] = bf_hi(r.w) + a1[3];
                *(f32x4*)(XO + off + bj * HALF) = x0; *(f32x4*)(XO + off + bj * HALF + 4) = x1;
#pragma unroll
                for (int j = 0; j < 4; ++j) q += x0[j] * x0[j] + x1[j] * x1[j]; }
            q += __shfl_xor(q, 16); q += __shfl_xor(q, 32);
            if (fq == 0) unsafeAtomicAdd(rowss + row, q); }
#undef EPI_LOAD
    }
};
__device__ __forceinline__ float dpp_shr1(float old, float x) { return __int_as_float(__builtin_amdgcn_update_dpp(__float_as_int(old), __float_as_int(x), 0x111, 0xf, 0xf, false)); }
__device__ __forceinline__ float gelu_mul(float g, float v) {
    const float t = g * (-2.3022082f + -0.10294324f * g * g);
    return g * v * __builtin_amdgcn_rcpf(1.0f + __builtin_amdgcn_exp2f(t)); }
struct EpiUpGate {
    static constexpr bool PERM = true, AFTER_DRAIN = false, PERMA = true;
    bf16_t* G; const float* rowss; const float* cw; const float* cb; float* HEAD; float* TAIL; PG8_LAS float* halo;
    __device__ __forceinline__ void operator()(f32x4 (&acc)[2][2][4][2], const Unit& u, int wr, int wc, int fr, int fq) const {
        const int row0 = u.pm * BM + wr * 64 + 4 * fr;
        const int cbase = u.pn * 128 + wc * 32 + 8 * fq;
        f32x4 wg[3], wv[3], bg, bv;
#pragma unroll
        for (int k = 0; k < 3; ++k) { wg[k] = *(const f32x4*)(cw + (size_t)k * 24576 + cbase); wv[k] = *(const f32x4*)(cw + (size_t)k * 24576 + 12288 + cbase); }
        bg = *(const f32x4*)(cb + cbase); bv = *(const f32x4*)(cb + 12288 + cbase);
#pragma unroll
        for (int ai = 0; ai < 2; ++ai) { const f32x4 q = *(const f32x4*)(rowss + row0 + ai * HALF);
#pragma unroll
            for (int m = 0; m < 4; ++m) { const float rs = 1.0f / sqrtf(q[m] * (1.0f / 4096.0f) + 1e-6f);
#pragma unroll
                for (int bj = 0; bj < 2; ++bj) { acc[ai][bj][m][0] *= rs; acc[ai][bj][m][1] *= rs; } } }
        const size_t tb = ((size_t)(u.pm * 96 + u.pn) * 2) * 256;
#pragma unroll
        for (int ai = 0; ai < 2; ++ai) { const int blk = 2 * ai + wr;
            if (fr == 15) {
#pragma unroll
                for (int bj = 0; bj < 2; ++bj)
#pragma unroll
                    for (int n = 0; n < 2; ++n)
#pragma unroll
                        for (int mm = 0; mm < 2; ++mm) { const f32x4 v = acc[ai][bj][2 + mm][n];
#pragma unroll
                            for (int e = 0; e < 4; ++e) halo[((blk * 4 + wc) * 4 + fq) * 32 + (bj * 8 + n * 4 + e) * 2 + mm] = v[e];
                            if (blk == 3) *(f32x4*)(TAIL + tb + (size_t)mm * 256 + bj * HALF + wc * 32 + 8 * fq + 4 * n) = v; } }
            if (blk == 0 && fr == 0) {
#pragma unroll
                for (int bj = 0; bj < 2; ++bj)
#pragma unroll
                    for (int n = 0; n < 2; ++n)
#pragma unroll
                        for (int mm = 0; mm < 2; ++mm) *(f32x4*)(HEAD + tb + (size_t)mm * 256 + bj * HALF + wc * 32 + 8 * fq + 4 * n) = acc[0][bj][mm][n]; } }
        asm volatile("s_waitcnt lgkmcnt(0)" ::: "memory"); __builtin_amdgcn_s_barrier(); asm volatile("" ::: "memory");
#pragma unroll
        for (int n = 0; n < 2; ++n) {
            if (n == 1) {
#pragma unroll
                for (int k = 0; k < 3; ++k) { wg[k] = *(const f32x4*)(cw + (size_t)k * 24576 + cbase + 4); wv[k] = *(const f32x4*)(cw + (size_t)k * 24576 + 12288 + cbase + 4); }
                bg = *(const f32x4*)(cb + cbase + 4); bv = *(const f32x4*)(cb + 12288 + cbase + 4); }
#pragma unroll
            for (int ai = 0; ai < 2; ++ai) { const int blk = 2 * ai + wr; const int pblk = blk > 0 ? blk - 1 : 0; const float hz = blk > 0 ? 1.0f : 0.0f;
                f32x4 q2[2], q3[2];
#pragma unroll
                for (int bj = 0; bj < 2; ++bj) {
                    const PG8_LAS f32x4* hp = (const PG8_LAS f32x4*)(halo + ((pblk * 4 + wc) * 4 + fq) * 32 + (bj * 8 + n * 4) * 2);
                    const f32x4 ha = hp[0] * hz, hb = hp[1] * hz;
                    q2[bj][0] = dpp_shr1(ha[0], acc[ai][bj][2][n][0]); q3[bj][0] = dpp_shr1(ha[1], acc[ai][bj][3][n][0]);
                    q2[bj][1] = dpp_shr1(ha[2], acc[ai][bj][2][n][1]); q3[bj][1] = dpp_shr1(ha[3], acc[ai][bj][3][n][1]);
                    q2[bj][2] = dpp_shr1(hb[0], acc[ai][bj][2][n][2]); q3[bj][2] = dpp_shr1(hb[1], acc[ai][bj][3][n][2]);
                    q2[bj][3] = dpp_shr1(hb[2], acc[ai][bj][2][n][3]); q3[bj][3] = dpp_shr1(hb[3], acc[ai][bj][3][n][3]); }
#pragma unroll
                for (int m = 0; m < 4; ++m) { const int row = row0 + ai * HALF + m;
                    const f32x4 s1g = (m == 0) ? q3[0] : acc[ai][0][m > 0 ? m - 1 : 0][n], s2g = (m == 0) ? q2[0] : (m == 1) ? q3[0] : acc[ai][0][m > 1 ? m - 2 : 0][n];
                    const f32x4 s1v = (m == 0) ? q3[1] : acc[ai][1][m > 0 ? m - 1 : 0][n], s2v = (m == 0) ? q2[1] : (m == 1) ? q3[1] : acc[ai][1][m > 1 ? m - 2 : 0][n];
                    const f32x4 cgt = bg + wg[0] * s2g + wg[1] * s1g + wg[2] * acc[ai][0][m][n], cvl = bv + wv[0] * s2v + wv[1] * s1v + wv[2] * acc[ai][1][m][n];
                    float o[4];
#pragma unroll
                    for (int e = 0; e < 4; ++e) o[e] = gelu_mul(cgt[e], cvl[e]);
                    u32x2 w; w.x = cvt_pk_bf16(o[0], o[1]); w.y = cvt_pk_bf16(o[2], o[3]);
                    *(u32x2*)(G + (size_t)row * 12288 + cbase + 4 * n) = w; } } }
    }
};

template <class Epi, class Sched, bool ALIGN_EPI = false, bool SP2 = false>
__device__ __forceinline__ void gemm_phase(PG8_LAS unsigned char* lds, const Gemm g, const Sched& S, const Epi& E) {
    int tid = threadIdx.x; asm volatile("" : "+v"(tid));
    const int wid = __builtin_amdgcn_readfirstlane(tid >> 6), lane = tid & 63, wr = wid >> 2, wc = wid & 3, fr = lane & 15, fq = lane >> 4;
    const int K = g.K, nt = K / BK;
    unsigned voffA[2], voffB[2];
#pragma unroll
    for (int i = 0; i < 2; ++i) { int R, C; stage_rc(tid * 16 + i * 8192, R, C); const int Rb = Epi::PERM ? ((R & ~31) + perm32(R & 31)) : R;
        const int Ra = Epi::PERMA ? ((R & 64) + 4 * (R & 15) + ((R >> 4) & 3)) : R;
        voffA[i] = (unsigned)(Ra * K + C) * 2u; voffB[i] = (unsigned)(Rb * K + C) * 2u; }
    const size_t kstep = (size_t)(BK * 2);
    const size_t hstep = (size_t)HALF * K * 2;
    const size_t tstep = 2 * hstep;
    const unsigned ldsw = (unsigned)wid * 1024u;
    const int aoff = lds_byte(wr * 64 + fr, fq * 8), boff = lds_byte(wc * 32 + fr, fq * 8);
#define PG8_SA(b, h) (((b) * 2 + (h)) * HTB)
#define PG8_SB(b, h) ((4 + (b) * 2 + (h)) * HTB)
#define PG8_STAGE(bufoff, gbase, voff) do { _Pragma("unroll") for (int _i = 0; _i < 2; ++_i) \
        __builtin_amdgcn_global_load_lds((const unsigned*)((const char*)(gbase) + (voff)[_i]), (PG8_LAS unsigned*)(lds + (bufoff) + ldsw + _i * 8192), 16, 0, 0); } while (0)
#define PG8_LDA(dst, b, h) do { _Pragma("unroll") for (int m = 0; m < 4; ++m) _Pragma("unroll") for (int k = 0; k < 2; ++k) dst[m][k] = *(const PG8_LAS bf16x8*)(lds + PG8_SA(b, h) + aoff + m * 2048 + k * 1024); } while (0)
#define PG8_LDB(dst, b, h) do { _Pragma("unroll") for (int n = 0; n < 2; ++n) _Pragma("unroll") for (int k = 0; k < 2; ++k) dst[n][k] = *(const PG8_LAS bf16x8*)(lds + PG8_SB(b, h) + boff + n * 2048 + k * 1024); } while (0)
#define PG8_MMA(ai, bj, At, Bt) do { __builtin_amdgcn_s_setprio(1); _Pragma("unroll") for (int m = 0; m < 4; ++m) _Pragma("unroll") for (int n = 0; n < 2; ++n) _Pragma("unroll") for (int k = 0; k < 2; ++k) \
        acc[ai][bj][m][n] = __builtin_amdgcn_mfma_f32_16x16x32_bf16(Bt[n][k], At[m][k], acc[ai][bj][m][n], 0, 0, 0); __builtin_amdgcn_s_setprio(0); } while (0)
#define PG8_WAIT_V(n) asm volatile("s_waitcnt vmcnt(" #n ")" ::: "memory")
#define PG8_WAIT_L(n) asm volatile("s_waitcnt lgkmcnt(" #n ")" ::: "memory")
#define PG8_BAR __builtin_amdgcn_s_barrier()
#define PG8_SCHED __builtin_amdgcn_sched_barrier(0)
    Unit cur, nxt; int ui = 0;
    if (!S.next(0, cur)) return;
    f32x4 acc[2][2][4][2];
#pragma unroll
    for (int a = 0; a < 2; ++a)
#pragma unroll
        for (int b = 0; b < 2; ++b)
#pragma unroll
            for (int m = 0; m < 4; ++m)
#pragma unroll
                for (int n = 0; n < 2; ++n) acc[a][b][m][n] = (f32x4){0.f, 0.f, 0.f, 0.f};
    bf16x8 At[4][2], B0[2][2], B1[2][2];
    const char* cA = (const char*)g.A + (size_t)cur.pm * tstep; const char* cB = (const char*)g.Bt + (size_t)cur.pn * tstep;
    S.a_ready(cur);
    if constexpr (SP2) {
        PG8_STAGE(PG8_SB(0, 0), cB, voffB); PG8_STAGE(PG8_SB(0, 1), cB + hstep, voffB); PG8_STAGE(PG8_SA(0, 0), cA, voffA); PG8_STAGE(PG8_SA(0, 1), cA + hstep, voffA);
        if (wr == 1) PG8_BAR;
        PG8_WAIT_V(2); PG8_BAR;
        PG8_STAGE(PG8_SB(1, 0), cB + kstep, voffB); PG8_STAGE(PG8_SA(1, 0), cA + kstep, voffA); PG8_STAGE(PG8_SB(1, 1), cB + hstep + kstep, voffB);
        PG8_WAIT_V(6); PG8_BAR;
    } else {
        PG8_STAGE(PG8_SB(0, 0), cB, voffB); PG8_STAGE(PG8_SA(0, 0), cA, voffA); PG8_STAGE(PG8_SB(0, 1), cB + hstep, voffB); PG8_STAGE(PG8_SA(0, 1), cA + hstep, voffA);
        if (wr == 1) PG8_BAR;
        PG8_WAIT_V(4); PG8_BAR;
        PG8_STAGE(PG8_SB(1, 0), cB + kstep, voffB); PG8_STAGE(PG8_SA(1, 0), cA + kstep, voffA); PG8_STAGE(PG8_SB(1, 1), cB + hstep + kstep, voffB);
        PG8_WAIT_V(6); PG8_BAR;
    }
    for (;;) {
        const bool has_next = S.next(ui + 1, nxt);
        const char* nA = has_next ? (const char*)g.A + (size_t)nxt.pm * tstep : cA; const char* nB = has_next ? (const char*)g.Bt + (size_t)nxt.pn * tstep : cB;
        for (int t = 0; t < nt; t += 2) {
            const bool last = (t == nt - 2);
            const char* a1 = cA + (size_t)(t + 1) * kstep;
            const char* a2 = last ? nA : cA + (size_t)(t + 2) * kstep; const char* b2 = last ? nB : cB + (size_t)(t + 2) * kstep;
            const char* a3 = a2 + kstep; const char* b3 = b2 + kstep;
            if (last && has_next) S.a_ready(nxt);
            if constexpr (SP2) {
            PG8_LDB(B0, 0, 0); PG8_LDB(B1, 0, 1); PG8_SCHED; PG8_LDA(At, 0, 0); PG8_STAGE(PG8_SA(1, 1), a1 + hstep, voffA);
            PG8_WAIT_V(8); PG8_WAIT_L(0); PG8_BAR; PG8_MMA(0, 0, At, B0); PG8_MMA(0, 1, At, B1); PG8_BAR; PG8_SCHED;
            PG8_LDA(At, 0, 1); PG8_STAGE(PG8_SB(0, 0), b2, voffB); PG8_STAGE(PG8_SB(0, 1), b2 + hstep, voffB); PG8_STAGE(PG8_SA(0, 0), a2, voffA);
            PG8_WAIT_V(8); PG8_WAIT_L(0); PG8_BAR; PG8_MMA(1, 0, At, B0); PG8_MMA(1, 1, At, B1); PG8_BAR; PG8_SCHED;
            PG8_LDB(B0, 1, 0); PG8_LDB(B1, 1, 1); PG8_SCHED; PG8_LDA(At, 1, 0); PG8_STAGE(PG8_SA(0, 1), a2 + hstep, voffA);
            PG8_WAIT_V(8); PG8_WAIT_L(0); PG8_BAR; PG8_MMA(0, 0, At, B0); PG8_MMA(0, 1, At, B1); PG8_BAR; PG8_SCHED;
            PG8_LDA(At, 1, 1); PG8_STAGE(PG8_SB(1, 0), b3, voffB); PG8_STAGE(PG8_SB(1, 1), b3 + hstep, voffB); PG8_STAGE(PG8_SA(1, 0), a3, voffA);
            PG8_WAIT_V(8); PG8_WAIT_L(0); PG8_BAR; PG8_MMA(1, 0, At, B0); PG8_MMA(1, 1, At, B1); PG8_BAR; PG8_SCHED;
            } else {
            PG8_LDB(B0, 0, 0); PG8_SCHED; PG8_LDA(At, 0, 0); PG8_STAGE(PG8_SA(1, 1), a1 + hstep, voffA);
            PG8_WAIT_L(8); PG8_BAR; PG8_WAIT_L(0); PG8_MMA(0, 0, At, B0); PG8_BAR; PG8_SCHED;
            PG8_LDB(B1, 0, 1); PG8_STAGE(PG8_SB(0, 0), b2, voffB);
            PG8_BAR; PG8_WAIT_L(0); PG8_MMA(0, 1, At, B1); PG8_BAR;
            PG8_LDA(At, 0, 1); PG8_STAGE(PG8_SA(0, 0), a2, voffA);
            PG8_BAR; PG8_WAIT_L(0); PG8_MMA(1, 0, At, B0); PG8_BAR; PG8_SCHED;
            PG8_STAGE(PG8_SB(0, 1), b2 + hstep, voffB);
            PG8_WAIT_V(6); PG8_BAR; PG8_MMA(1, 1, At, B1); PG8_BAR;
            PG8_LDB(B0, 1, 0); PG8_SCHED; PG8_LDA(At, 1, 0); PG8_STAGE(PG8_SA(0, 1), a2 + hstep, voffA);
            PG8_WAIT_L(8); PG8_BAR; PG8_WAIT_L(0); PG8_MMA(0, 0, At, B0); PG8_BAR; PG8_SCHED;
            PG8_LDB(B1, 1, 1); PG8_STAGE(PG8_SB(1, 0), b3, voffB);
            PG8_BAR; PG8_WAIT_L(0); PG8_MMA(0, 1, At, B1); PG8_BAR;
            PG8_LDA(At, 1, 1); PG8_STAGE(PG8_SA(1, 0), a3, voffA);
            PG8_BAR; PG8_WAIT_L(0); PG8_MMA(1, 0, At, B0); PG8_BAR; PG8_SCHED;
            PG8_STAGE(PG8_SB(1, 1), b3 + hstep, voffB);
            PG8_WAIT_V(6); PG8_BAR; PG8_MMA(1, 1, At, B1); PG8_BAR;
            }
        }
        if constexpr (ALIGN_EPI) { if (wr == 0) PG8_BAR; }
        E(acc, cur, wr, wc, fr, fq); S.done(cur);
        if (!has_next) break;
#pragma unroll
        for (int a = 0; a < 2; ++a)
#pragma unroll
            for (int b = 0; b < 2; ++b)
#pragma unroll
                for (int m = 0; m < 4; ++m)
#pragma unroll
                    for (int n = 0; n < 2; ++n) acc[a][b][m][n] = (f32x4){0.f, 0.f, 0.f, 0.f};
        cur = nxt; cA = nA; cB = nB; ++ui;
        if constexpr (ALIGN_EPI) { if (wr == 1) PG8_BAR; }
    }
    PG8_WAIT_V(0);
    if constexpr (!ALIGN_EPI) { if (wr == 0) PG8_BAR; }
    PG8_BAR;
#undef PG8_SA
#undef PG8_SB
#undef PG8_STAGE
#undef PG8_LDA
#undef PG8_LDB
#undef PG8_MMA
#undef PG8_WAIT_V
#undef PG8_WAIT_L
#undef PG8_BAR
#undef PG8_SCHED
}
template <class Epi, class Sched>
__device__ __forceinline__ void gemm_phase_dual(PG8_LAS unsigned char* lds, const Gemm g  , const bf16_t* A0, const bf16_t* Bt0, int K0, const Sched& S, const Epi& E) {
    int tid = threadIdx.x; asm volatile("" : "+v"(tid));
    const int wid = __builtin_amdgcn_readfirstlane(tid >> 6), lane = tid & 63, wr = wid >> 2, wc = wid & 3, fr = lane & 15, fq = lane >> 4;
    const int K = g.K;
    unsigned voffA[2], voffB[2];
#pragma unroll
    for (int i = 0; i < 2; ++i) { int R, C; stage_rc(tid * 16 + i * 8192, R, C); const int Rb = Epi::PERM ? ((R & ~31) + perm32(R & 31)) : R;
        voffA[i] = (unsigned)(R * K + C) * 2u; voffB[i] = (unsigned)(Rb * K + C) * 2u; }
    const size_t kstep = (size_t)(BK * 2);
    const size_t hstep = (size_t)HALF * K * 2;
    const size_t tstep = 2 * hstep;
    const unsigned ldsw = (unsigned)wid * 1024u;
    const int aoff = lds_byte(wr * 64 + fr, fq * 8), boff = lds_byte(wc * 32 + fr, fq * 8);
#define PG8_SA(b, h) (((b) * 2 + (h)) * HTB)
#define PG8_SB(b, h) ((4 + (b) * 2 + (h)) * HTB)
#define PG8_STAGE(bufoff, gbase, voff) do { _Pragma("unroll") for (int _i = 0; _i < 2; ++_i) \
        __builtin_amdgcn_global_load_lds((const unsigned*)((const char*)(gbase) + (voff)[_i]), (PG8_LAS unsigned*)(lds + (bufoff) + ldsw + _i * 8192), 16, 0, 0); } while (0)
#define PG8_LDA(dst, b, h) do { _Pragma("unroll") for (int m = 0; m < 4; ++m) _Pragma("unroll") for (int k = 0; k < 2; ++k) dst[m][k] = *(const PG8_LAS bf16x8*)(lds + PG8_SA(b, h) + aoff + m * 2048 + k * 1024); } while (0)
#define PG8_LDB(dst, b, h) do { _Pragma("unroll") for (int n = 0; n < 2; ++n) _Pragma("unroll") for (int k = 0; k < 2; ++k) dst[n][k] = *(const PG8_LAS bf16x8*)(lds + PG8_SB(b, h) + boff + n * 2048 + k * 1024); } while (0)
#define PG8_MMA(ai, bj, At, Bt) do { __builtin_amdgcn_s_setprio(1); _Pragma("unroll") for (int m = 0; m < 4; ++m) _Pragma("unroll") for (int n = 0; n < 2; ++n) _Pragma("unroll") for (int k = 0; k < 2; ++k) \
        acc[ai][bj][m][n] = __builtin_amdgcn_mfma_f32_16x16x32_bf16(Bt[n][k], At[m][k], acc[ai][bj][m][n], 0, 0, 0); __builtin_amdgcn_s_setprio(0); } while (0)
#define PG8_WAIT_V(n) asm volatile("s_waitcnt vmcnt(" #n ")" ::: "memory")
#define PG8_WAIT_L(n) asm volatile("s_waitcnt lgkmcnt(" #n ")" ::: "memory")
#define PG8_BAR __builtin_amdgcn_s_barrier()
#define PG8_SCHED __builtin_amdgcn_sched_barrier(0)
    Unit cur, nxt; int ui = 0;
    if (!S.next(0, cur)) return;
    f32x4 acc[2][2][4][2];
#pragma unroll
    for (int a = 0; a < 2; ++a)
#pragma unroll
        for (int b = 0; b < 2; ++b)
#pragma unroll
            for (int m = 0; m < 4; ++m)
#pragma unroll
                for (int n = 0; n < 2; ++n) acc[a][b][m][n] = (f32x4){0.f, 0.f, 0.f, 0.f};
    bf16x8 At[4][2], B0[2][2], B1[2][2];
    const char* cA = (const char*)A0 + (size_t)cur.pm * tstep; const char* cB = (const char*)Bt0 + (size_t)cur.pn * tstep;
    PG8_STAGE(PG8_SB(0, 0), cB, voffB); PG8_STAGE(PG8_SB(0, 1), cB + hstep, voffB); PG8_STAGE(PG8_SA(0, 0), cA, voffA); PG8_STAGE(PG8_SA(0, 1), cA + hstep, voffA);
    if (wr == 1) PG8_BAR;
    PG8_WAIT_V(2); PG8_BAR;
    PG8_STAGE(PG8_SB(1, 0), cB + kstep, voffB); PG8_STAGE(PG8_SA(1, 0), cA + kstep, voffA); PG8_STAGE(PG8_SB(1, 1), cB + hstep + kstep, voffB);
    PG8_WAIT_V(6); PG8_BAR;
#define PG8_KLOOP(NT, CA, CB, NA, NB) for (int t = 0; t < (NT); t += 2) { \
            const bool last = (t == (NT) - 2); \
            const char* a1 = (CA) + (size_t)(t + 1) * kstep; \
            const char* a2 = last ? (NA) : (CA) + (size_t)(t + 2) * kstep; const char* b2 = last ? (NB) : (CB) + (size_t)(t + 2) * kstep; \
            const char* a3 = a2 + kstep; const char* b3 = b2 + kstep; \
            PG8_LDB(B0, 0, 0); PG8_LDB(B1, 0, 1); PG8_SCHED; PG8_LDA(At, 0, 0); PG8_STAGE(PG8_SA(1, 1), a1 + hstep, voffA); \
            PG8_WAIT_V(8); PG8_WAIT_L(0); PG8_BAR; PG8_MMA(0, 0, At, B0); PG8_MMA(0, 1, At, B1); PG8_BAR; PG8_SCHED; \
            PG8_LDA(At, 0, 1); PG8_STAGE(PG8_SB(0, 0), b2, voffB); PG8_STAGE(PG8_SB(0, 1), b2 + hstep, voffB); PG8_STAGE(PG8_SA(0, 0), a2, voffA); \
            PG8_WAIT_V(8); PG8_WAIT_L(0); PG8_BAR; PG8_MMA(1, 0, At, B0); PG8_MMA(1, 1, At, B1); PG8_BAR; PG8_SCHED; \
            PG8_LDB(B0, 1, 0); PG8_LDB(B1, 1, 1); PG8_SCHED; PG8_LDA(At, 1, 0); PG8_STAGE(PG8_SA(0, 1), a2 + hstep, voffA); \
            PG8_WAIT_V(8); PG8_WAIT_L(0); PG8_BAR; PG8_MMA(0, 0, At, B0); PG8_MMA(0, 1, At, B1); PG8_BAR; PG8_SCHED; \
            PG8_LDA(At, 1, 1); PG8_STAGE(PG8_SB(1, 0), b3, voffB); PG8_STAGE(PG8_SB(1, 1), b3 + hstep, voffB); PG8_STAGE(PG8_SA(1, 0), a3, voffA); \
            PG8_WAIT_V(8); PG8_WAIT_L(0); PG8_BAR; PG8_MMA(1, 0, At, B0); PG8_MMA(1, 1, At, B1); PG8_BAR; PG8_SCHED; }
    const int nt0 = K0 / BK, nt1 = K / BK;
    for (;;) {
        const char* mA = (const char*)g.A + (size_t)cur.pm * tstep; const char* mB = (const char*)g.Bt + (size_t)cur.pn * tstep;
        PG8_KLOOP(nt0, cA, cB, mA, mB)
        E.mid(acc, cur, wr, wc, fr, fq);
        const bool has_next = S.next(ui + 1, nxt);
        const char* nA = has_next ? (const char*)A0 + (size_t)nxt.pm * tstep : mA; const char* nB = has_next ? (const char*)Bt0 + (size_t)nxt.pn * tstep : mB;
        PG8_KLOOP(nt1, mA, mB, nA, nB)
        if (wr == 0) PG8_BAR;
        E(acc, cur, wr, wc, fr, fq);
        if (!has_next) break;
#pragma unroll
        for (int a = 0; a < 2; ++a)
#pragma unroll
            for (int b = 0; b < 2; ++b)
#pragma unroll
                for (int m = 0; m < 4; ++m)
#pragma unroll
                    for (int n = 0; n < 2; ++n) acc[a][b][m][n] = (f32x4){0.f, 0.f, 0.f, 0.f};
        cur = nxt; cA = nA; cB = nB; ++ui;
        if (wr == 1) PG8_BAR;
    }
#undef PG8_KLOOP
    PG8_WAIT_V(0);
    PG8_BAR;
#undef PG8_SA
#undef PG8_SB
#undef PG8_STAGE
#undef PG8_LDA
#undef PG8_LDB
#undef PG8_MMA
#undef PG8_WAIT_V
#undef PG8_WAIT_L
#undef PG8_BAR
#undef PG8_SCHED
}
}


#ifndef PG8_SP2
#define PG8_SP2 true
#endif
#ifndef PG8_ALIGN
#define PG8_ALIGN true
#endif

constexpr int NWAVES = 8;
constexpr int N_LAUNCHES = MK_N_LAUNCHES;
constexpr int NPH = 9;
constexpr int DM = 4096, SEQ = 2048, NB = 4, M = NB * SEQ;
constexpr int SGW = 2048, SGD = 256, CHUNK = 128;
constexpr int LW = 4096, LH = 16, LHD = 256;
constexpr int FFW = 12288, UPN = 2 * FFW, INC = 20480;
constexpr float EPS = 1e-6f;

constexpr size_t MiB = 1u << 20;
constexpr size_t WS_CTL = 0, CTL_ZERO_BYTES = 1 * MiB;
constexpr size_t WS_WIN = 2 * MiB, WS_WUP = 162 * MiB, WS_WDN = 354 * MiB, WS_PA = 450 * MiB, WS_PB = 482 * MiB, WS_WOUT = 514 * MiB, WS_WA = 546 * MiB, WS_WX = 548 * MiB;
constexpr size_t WS_H = 552 * MiB, WS_GU = 616 * MiB, WS_GV = 648 * MiB, WS_XR = 680 * MiB, WS_GYR = 744 * MiB, WS_SGA = 808 * MiB, WS_SGB = 872 * MiB;
constexpr size_t WS_YA = 936 * MiB  , WS_YB = 1000 * MiB, WS_MRG = 1064 * MiB, WS_X1B = 1128 * MiB, WS_END = 1192 * MiB;
constexpr size_t WS_HEAD = 552 * MiB, WS_TAIL = 560 * MiB;
constexpr size_t WS_G = 616 * MiB;
static_assert(WS_TAIL + (size_t)32 * 96 * 2 * 256 * 4 <= WS_GU && WS_G + (size_t)M * FFW * 2 <= WS_SGA, "overlay map");
constexpr int CW_TMO = 0;
constexpr int CW_BAR = 4096;
constexpr int CW_VSUM = 16384, CW_VSQ = CW_VSUM + M, CW_RSS2 = CW_VSQ + M, CW_RSS3 = CW_RSS2 + M, CW_DUMMY = CW_RSS3 + M;
static_assert((CW_DUMMY + 2 * M) * 4 <= (int)CTL_ZERO_BYTES, "CTL words inside the memset region");

constexpr int LDS_BYTES = 155648;
constexpr int MISC_OFF = 154624;
constexpr int HALO_OFF = 131072;

#define LAS __attribute__((address_space(3)))
typedef unsigned short bf16;
typedef float f32x4 __attribute__((ext_vector_type(4)));
typedef unsigned u32x4 __attribute__((ext_vector_type(4)));
typedef unsigned u32x2 __attribute__((ext_vector_type(2)));
typedef short bf16x8 __attribute__((ext_vector_type(8)));
#define LDS_WAIT() asm volatile("s_waitcnt lgkmcnt(0)" ::: "memory")
#define VM_WAIT() asm volatile("s_waitcnt vmcnt(0)" ::: "memory")
#define LDS_BARRIER() do { asm volatile("s_waitcnt lgkmcnt(0)" ::: "memory"); __builtin_amdgcn_s_barrier(); asm volatile("" ::: "memory"); } while (0)
using pg8::cvt_pk_bf16; using pg8::bf_lo; using pg8::bf_hi; using pg8::sigmoid_f; using pg8::gelu_tanh_f;

#define XB_TMO      128
#define XB_XCNT(j)  (256  + 64 * (j))
#define XB_XSUB(j)  (1280 + 64 * (j))
#define XB_XGEN(j)  (2304 + 64 * (j))
#define XB_TOP      3328
#define XB_TOPGEN   3392
#define XCD_BAR_WORDS 3456
#define XB_SPIN_CAP (1u << 18)
__device__ __forceinline__ unsigned xb_ld(unsigned* p)              { return __hip_atomic_load(p, __ATOMIC_RELAXED, __HIP_MEMORY_SCOPE_AGENT); }
__device__ __forceinline__ unsigned xb_add(unsigned* p, unsigned v) { return __hip_atomic_fetch_add(p, v, __ATOMIC_RELAXED, __HIP_MEMORY_SCOPE_AGENT); }
__device__ __forceinline__ unsigned xb_xcc_id() { return (unsigned)__builtin_amdgcn_s_getreg((3 << 11) | 20) & 0xFu; }
#define XB_SPIN(cond, bar) do { unsigned _sp = 0; while (cond) { __builtin_amdgcn_s_sleep(1); \
    if ((++_sp & 255u) == 0u) { if (xb_ld(&(bar)[XB_TMO])) break; if (_sp > XB_SPIN_CAP) { atomicAdd(&(bar)[XB_TMO], 1u); break; } } } } while (0)
struct XcdBarrier { unsigned* bar; unsigned x; volatile LAS unsigned* st; };
__device__ __forceinline__ XcdBarrier xcd_barrier_post(unsigned* bar, volatile LAS unsigned* st) {
    XcdBarrier b; b.bar = bar; b.x = xb_xcc_id(); b.st = st;
    if (threadIdx.x == 0) (void)xb_add(&bar[XB_XCNT(b.x)], 1u);
    return b;
}
__device__ __forceinline__ void xcd_barrier_complete(unsigned* bar, unsigned x, unsigned& nloc, unsigned& nx) {
    const unsigned G = gridDim.x * gridDim.y * gridDim.z;
    unsigned sum, cnt, mine, sp = 0u;
    for (;;) {
        sum = 0u; cnt = 0u; mine = 0u;
#pragma unroll
        for (unsigned j = 0; j < 16; ++j) { const unsigned c = xb_ld(&bar[XB_XCNT(j)]); sum += c; cnt += (c > 0u) ? 1u : 0u; mine = (j == x) ? c : mine; }
        if (sum == G) break;
        __builtin_amdgcn_s_sleep(1);
        if ((++sp & 255u) == 0u) { if (xb_ld(&bar[XB_TMO])) break; if (sp > XB_SPIN_CAP) { atomicAdd(&bar[XB_TMO], 1u); break; } }
    }
    nloc = mine > 0u ? mine : 1u; nx = cnt > 0u ? cnt : 1u;
}
__device__ __forceinline__ void xcd_barrier(const XcdBarrier& b) {
    asm volatile("s_waitcnt vmcnt(0)" ::: "memory");
    __syncthreads();
    if (threadIdx.x == 0) {
        unsigned* bar = b.bar;
        __builtin_amdgcn_s_waitcnt(0);
        unsigned nloc = b.st[0], nx = b.st[1];
        if (nloc == 0u) { xcd_barrier_complete(bar, b.x, nloc, nx); b.st[0] = nloc; b.st[1] = nx; }
        const unsigned old = xb_add(&bar[XB_XSUB(b.x)], 1u);
        const unsigned gen = old / nloc;
        if (old + 1u == (gen + 1u) * nloc) {
            __builtin_amdgcn_fence(__ATOMIC_RELEASE, "agent");
            asm volatile("s_waitcnt vmcnt(0)" ::: "memory");
            const unsigned og = xb_add(&bar[XB_TOP], 1u);
            const unsigned tg = og / nx;
            if (og + 1u == (tg + 1u) * nx) xb_add(&bar[XB_TOPGEN], 1u);
            else XB_SPIN(xb_ld(&bar[XB_TOPGEN]) == tg, bar);
            __builtin_amdgcn_fence(__ATOMIC_ACQUIRE, "agent");
            xb_add(&bar[XB_XGEN(b.x)], 1u);
            asm volatile("s_waitcnt vmcnt(0)" ::: "memory");
        } else {
            XB_SPIN(xb_ld(&bar[XB_XGEN(b.x)]) == gen, bar);
            __builtin_amdgcn_fence(__ATOMIC_ACQUIRE, "agent");
            asm volatile("s_waitcnt vmcnt(0)" ::: "memory");
        }
    }
    __syncthreads();
}

__device__ __forceinline__ int opaque_tid() { int t = threadIdx.x; asm volatile("" : "+v"(t)); return t; }
__device__ __forceinline__ float wave_sum(float v) {
#pragma unroll
    for (int o = 1; o < 64; o <<= 1) v += __shfl_xor(v, o);
    return v;
}
__device__ __forceinline__ void tr_tile(const float* __restrict__ W, int ldw, bf16* __restrict__ WT, int ldt, int k0, int n0, int dn0, const float* __restrict__ gain, LAS unsigned* scr, int lane) {
    const int nl = (lane & 15) * 4, kq = lane >> 4;
    f32x4 v[16];
#pragma unroll
    for (int i = 0; i < 8; ++i)
#pragma unroll
        for (int h = 0; h < 2; ++h) v[2 * i + h] = *(const f32x4*)(W + (size_t)(k0 + 8 * i + 2 * kq + h) * ldw + n0 + nl);
    if (gain) {
#pragma unroll
        for (int i = 0; i < 8; ++i)
#pragma unroll
            for (int h = 0; h < 2; ++h) v[2 * i + h] *= gain[k0 + 8 * i + 2 * kq + h]; }
#pragma unroll
    for (int i = 0; i < 8; ++i)
#pragma unroll
        for (int j = 0; j < 4; ++j) scr[(nl + j) * 33 + 4 * i + kq] = cvt_pk_bf16(v[2 * i][j], v[2 * i + 1][j]);
    LDS_WAIT(); asm volatile("" ::: "memory");
    const int c = lane & 7, nr = lane >> 3;
#pragma unroll
    for (int it = 0; it < 8; ++it) { const int n = 8 * it + nr; const LAS unsigned* s = scr + n * 33 + 4 * c;
        u32x4 o; o.x = s[0]; o.y = s[1]; o.z = s[2]; o.w = s[3];
        *(u32x4*)(WT + (size_t)(dn0 + n) * ldt + k0 + 8 * c) = o; }
    LDS_WAIT(); asm volatile("" ::: "memory");
}

struct Args { const float* in[23]; float* out; unsigned char* ws; int ph_lo, ph_hi; };

__device__ __forceinline__ void p0_prologue(const Args& a, LAS unsigned char* lds, int vcu, int G) {
    const int tid = opaque_tid(), lane = tid & 63, wave = __builtin_amdgcn_readfirstlane(tid >> 6);
    unsigned char* ws = a.ws;
    LAS unsigned* scr = (LAS unsigned*)(lds + wave * 8448);
    const int gw = vcu * NWAVES + wave, NGW = G * NWAVES;
    constexpr int T_IN = (DM / 64) * (INC / 64), T_UP = (DM / 64) * (UPN / 64), T_DN = (FFW / 64) * (DM / 64), T_PA = (SGW / 64) * (DM / 64), T_PB = (LW / 64) * (DM / 64), T_WO = (DM / 64) * (DM / 64), T_G = LH * 16;
    constexpr int NT = T_IN + T_UP + T_DN + T_PA + T_PB + T_WO + 2 * T_G;
    for (int it = gw; it < NT; it += NGW) {
        int r = it;
        if (r < T_IN) { const int nb = INC / 64; tr_tile(a.in[2], INC, (bf16*)(ws + WS_WIN), DM, 64 * (r / nb), 64 * (r % nb), 64 * (r % nb), nullptr, scr, lane); continue; } r -= T_IN;
        if (r < T_UP) { const int nb = UPN / 64; const int n0 = 64 * (r % nb); const int ch = (n0 < FFW) ? n0 : n0 - FFW; const int dn0 = (ch >> 7) * 256 + (ch & 127) + ((n0 < FFW) ? 0 : 128);
          tr_tile(a.in[18], UPN, (bf16*)(ws + WS_WUP), DM, 64 * (r / nb), n0, dn0, a.in[17], scr, lane); continue; } r -= T_UP;
        if (r < T_DN) { const int nb = DM / 64; tr_tile(a.in[21], DM, (bf16*)(ws + WS_WDN), FFW, 64 * (r / nb), 64 * (r % nb), 64 * (r % nb), nullptr, scr, lane); continue; } r -= T_DN;
        if (r < T_PA) { const int nb = DM / 64; tr_tile(a.in[14], DM, (bf16*)(ws + WS_PA), LW  , 64 * (r / nb), 64 * (r % nb), 64 * (r % nb), nullptr, scr, lane); continue; } r -= T_PA;
        if (r < T_PB) { const int nb = DM / 64; tr_tile(a.in[15], DM, (bf16*)(ws + WS_PB), LW, 64 * (r / nb), 64 * (r % nb), 64 * (r % nb), nullptr, scr, lane); continue; } r -= T_PB;
        if (r < T_WO) { const int nb = DM / 64; tr_tile(a.in[16], DM, (bf16*)(ws + WS_WOUT), DM, 64 * (r / nb), 64 * (r % nb), 64 * (r % nb), nullptr, scr, lane); continue; } r -= T_WO;
        if (r < T_G) { const int hd = r >> 4, t = r & 15; tr_tile(a.in[9] + (size_t)hd * LHD * LHD, LHD, (bf16*)(ws + WS_WA) + (size_t)hd * LHD * LHD, LHD, 64 * (t >> 2), 64 * (t & 3), 64 * (t & 3), nullptr, scr, lane); continue; } r -= T_G;
        { const int hd = r >> 4, t = r & 15; tr_tile(a.in[11] + (size_t)hd * LHD * LHD, LHD, (bf16*)(ws + WS_WX) + (size_t)hd * LHD * LHD, LHD, 64 * (t >> 2), 64 * (t & 3), 64 * (t & 3), nullptr, scr, lane); }
    }
    const float* x = a.in[0]; const f32x4* gm = (const f32x4*)a.in[1] + lane; bf16* H = (bf16*)(ws + WS_H);
    for (int m = gw; m < M; m += NGW) {
        const f32x4* xr = (const f32x4*)(x + (size_t)m * DM) + lane; f32x4 v[16]; float s = 0.f;
#pragma unroll
        for (int j = 0; j < 16; ++j) { v[j] = xr[64 * j]; s += (v[j][0] * v[j][0] + v[j][1] * v[j][1]) + (v[j][2] * v[j][2] + v[j][3] * v[j][3]); }
        const float rs = 1.0f / sqrtf(wave_sum(s) * (1.0f / DM) + EPS);
        u32x2* o = (u32x2*)(H + (size_t)m * DM) + lane;
#pragma unroll
        for (int j = 0; j < 16; ++j) { const f32x4 g = gm[64 * j]; u32x2 w; w.x = cvt_pk_bf16(v[j][0] * rs * g[0], v[j][1] * rs * g[1]); w.y = cvt_pk_bf16(v[j][2] * rs * g[2], v[j][3] * rs * g[3]); o[64 * j] = w; }
    }
}

constexpr int MA_PITCH = 272;
constexpr int MA_WT = 0, MA_VN = 128 * MA_PITCH;
__device__ __forceinline__ void mixer_a_unit(const Args& a, LAS unsigned char* lds, int unit) {
    const int tid = opaque_tid(), lane = tid & 63, wave = __builtin_amdgcn_readfirstlane(tid >> 6);
    unsigned char* ws = a.ws;
    const int g = unit & 7, bc = unit >> 3;
    const int R0 = bc * CHUNK, C0 = g * SGD;
    const bf16* GU = (const bf16*)(ws + WS_GU); const bf16* GV = (const bf16*)(ws + WS_GV); bf16* YA = (bf16*)(ws + WS_YA);
    const float* vsum = (const float*)(ws + WS_CTL) + CW_VSUM; const float* vsq = (const float*)(ws + WS_CTL) + CW_VSQ;
    { const int t = tid >> 2, sq = tid & 3; const float* src = a.in[5] + ((size_t)g * CHUNK + t) * CHUNK + 32 * sq;
#pragma unroll
      for (int i = 0; i < 4; ++i) { const f32x4 w0 = *(const f32x4*)(src + 8 * i), w1 = *(const f32x4*)(src + 8 * i + 4); const int s0 = 32 * sq + 8 * i;
          float e[8] = {w0[0], w0[1], w0[2], w0[3], w1[0], w1[1], w1[2], w1[3]};
#pragma unroll
          for (int j = 0; j < 8; ++j) e[j] = (s0 + j <= t) ? e[j] : 0.f;
          u32x4 o; o.x = cvt_pk_bf16(e[0], e[1]); o.y = cvt_pk_bf16(e[2], e[3]); o.z = cvt_pk_bf16(e[4], e[5]); o.w = cvt_pk_bf16(e[6], e[7]);
          *(LAS u32x4*)(lds + MA_WT + t * MA_PITCH + s0 * 2) = o; } }
    { const int s0 = 2 * lane; const int r0 = R0 + s0;
      const float mu0 = vsum[r0] * (1.0f / SGW), mu1 = vsum[r0 + 1] * (1.0f / SGW);
      const float rs0 = 1.0f / sqrtf(fmaxf(vsq[r0] * (1.0f / SGW) - mu0 * mu0, 0.f) + EPS), rs1 = 1.0f / sqrtf(fmaxf(vsq[r0 + 1] * (1.0f / SGW) - mu1 * mu1, 0.f) + EPS);
#pragma unroll
      for (int it = 0; it < 4; ++it) { const int cg = wave * 4 + it; const int col = C0 + 8 * cg;
          const u32x4 q0 = *(const u32x4*)(GV + (size_t)r0 * SGW + col), q1 = *(const u32x4*)(GV + (size_t)(r0 + 1) * SGW + col);
          const f32x4 lg0 = *(const f32x4*)(a.in[3] + col), lg1 = *(const f32x4*)(a.in[3] + col + 4), lb0 = *(const f32x4*)(a.in[4] + col), lb1 = *(const f32x4*)(a.in[4] + col + 4);
          const float x0[8] = {bf_lo(q0.x), bf_hi(q0.x), bf_lo(q0.y), bf_hi(q0.y), bf_lo(q0.z), bf_hi(q0.z), bf_lo(q0.w), bf_hi(q0.w)};
          const float x1[8] = {bf_lo(q1.x), bf_hi(q1.x), bf_lo(q1.y), bf_hi(q1.y), bf_lo(q1.z), bf_hi(q1.z), bf_lo(q1.w), bf_hi(q1.w)};
          const float lg[8] = {lg0[0], lg0[1], lg0[2], lg0[3], lg1[0], lg1[1], lg1[2], lg1[3]}, lb[8] = {lb0[0], lb0[1], lb0[2], lb0[3], lb1[0], lb1[1], lb1[2], lb1[3]};
#pragma unroll
          for (int j = 0; j < 8; ++j) { const float n0 = (x0[j] - mu0) * rs0 * lg[j] + lb[j], n1 = (x1[j] - mu1) * rs1 * lg[j] + lb[j];
              *(LAS unsigned*)(lds + MA_VN + (8 * cg + j) * MA_PITCH + 4 * lane) = cvt_pk_bf16(n0, n1); } } }
    LDS_WAIT(); __syncthreads();
    const int fr = lane & 15, fq = lane >> 4;
    f32x4 acc[8][2];
#pragma unroll
    for (int m = 0; m < 8; ++m) { acc[m][0] = (f32x4){0.f, 0.f, 0.f, 0.f}; acc[m][1] = (f32x4){0.f, 0.f, 0.f, 0.f}; }
#pragma unroll
    for (int ks = 0; ks < 4; ++ks) {
        bf16x8 vf[2];
#pragma unroll
        for (int n = 0; n < 2; ++n) vf[n] = *(const LAS bf16x8*)(lds + MA_VN + (32 * wave + 16 * n + fr) * MA_PITCH + (32 * ks + 8 * fq) * 2);
#pragma unroll
        for (int m = 0; m < 8; ++m) { if (32 * ks > 16 * m + 15) continue;
            const bf16x8 wf = *(const LAS bf16x8*)(lds + MA_WT + (16 * m + fr) * MA_PITCH + (32 * ks + 8 * fq) * 2);
#pragma unroll
            for (int n = 0; n < 2; ++n) acc[m][n] = __builtin_amdgcn_mfma_f32_16x16x32_bf16(vf[n], wf, acc[m][n], 0, 0, 0); }
    }
#pragma unroll
    for (int m = 0; m < 8; ++m) { const int t = 16 * m + fr; const float bs = a.in[6][g * CHUNK + t];
#pragma unroll
        for (int n = 0; n < 2; ++n) { const size_t off = (size_t)(R0 + t) * SGW + C0 + 32 * wave + 16 * n + 4 * fq, offy = (size_t)(R0 + t) * LW + C0 + 32 * wave + 16 * n + 4 * fq; const u32x2 gu = *(const u32x2*)(GU + off);
            u32x2 o; o.x = cvt_pk_bf16(bf_lo(gu.x) * (acc[m][n][0] + bs), bf_hi(gu.x) * (acc[m][n][1] + bs)); o.y = cvt_pk_bf16(bf_lo(gu.y) * (acc[m][n][2] + bs), bf_hi(gu.y) * (acc[m][n][3] + bs));
            *(u32x2*)(YA + offy) = o; } }
    __syncthreads();
}

constexpr int MB_XPITCH = 528;
constexpr int MB_XC = 0, MB_AG = 128 * MB_XPITCH  , MB_CTAB = MB_AG + 128 * 65 * 8  ;
static_assert(MB_CTAB + 5 * 256 * 4 <= MISC_OFF, "mixer B LDS map");
typedef float f32x2 __attribute__((ext_vector_type(2)));
__device__ __forceinline__ void mixer_b_unit(const Args& a, LAS unsigned char* lds, int unit) {
    const int tid = opaque_tid(), lane = tid & 63, wave = __builtin_amdgcn_readfirstlane(tid >> 6);
    unsigned char* ws = a.ws;
    const int q = unit & 3, hd = (unit >> 2) & 15, b = unit >> 6;
    const int HC = hd * LHD, OC = HC + 64 * q;
    const bf16* XR = (const bf16*)(ws + WS_XR); const bf16* GYR = (const bf16*)(ws + WS_GYR); bf16* YB = (bf16*)(ws + WS_YB);
    const bf16* WaT = (const bf16*)(ws + WS_WA) + (size_t)hd * LHD * LHD; const bf16* WxT = (const bf16*)(ws + WS_WX) + (size_t)hd * LHD * LHD;
    const int fr = lane & 15, fq = lane >> 4, cb = wave & 3, rh = wave >> 2;
    bf16x8 bfa[8], bfx[8];
#pragma unroll
    for (int ks = 0; ks < 8; ++ks) { const size_t o = (size_t)(64 * q + 16 * cb + fr) * LHD + 32 * ks + 8 * fq; bfa[ks] = *(const bf16x8*)(WaT + o); bfx[ks] = *(const bf16x8*)(WxT + o); }
    float ba[4], bx[4], sp[4];
#pragma unroll
    for (int e = 0; e < 4; ++e) { const int col = OC + 16 * cb + 4 * fq + e; ba[e] = a.in[10][col]; bx[e] = a.in[12][col]; sp[e] = -8.0f * log1pf(expf(-a.in[13][col])); }
    const int cg = tid & 31, rg = tid >> 5;
    LAS float* ctab = (LAS float*)(lds + MB_CTAB);
    for (int i = tid; i < 5 * LHD; i += NWAVES * 64) { const int k = i >> 8, c = i & 255; ctab[i] = (k < 4) ? a.in[7][(size_t)k * LW + HC + c] : a.in[8][HC + c]; }
    LAS f32x2* ag = (LAS f32x2*)(lds + MB_AG);
    const int c8 = lane & 7, rgp = lane >> 3;
    float carry = 0.f;
    const bf16* xrp = XR + ((size_t)b * SEQ + 8 * rg) * LW + HC + 8 * cg;
    u32x4 raw[11];
#pragma unroll
    for (int i = 0; i < 11; ++i) raw[i] = (8 * rg - 3 + i >= 0) ? *(const u32x4*)(xrp + (ptrdiff_t)(i - 3) * LW) : (u32x4){0u, 0u, 0u, 0u};
    LDS_WAIT(); __syncthreads();
    for (int step = 0; step < SEQ / 128; ++step) {
        const int t0 = step * 128; const size_t rowbase = (size_t)b * SEQ + t0;
        { f32x4 cw[5][2];
#pragma unroll
          for (int k = 0; k < 5; ++k) { cw[k][0] = *(const LAS f32x4*)(ctab + k * LHD + 8 * cg); cw[k][1] = *(const LAS f32x4*)(ctab + k * LHD + 8 * cg + 4); }
#pragma unroll
          for (int r = 0; r < 8; ++r) { float o[8];
#pragma unroll
              for (int j = 0; j < 8; ++j) o[j] = cw[4][j >> 2][j & 3];
#pragma unroll
              for (int k = 0; k < 4; ++k) { const u32x4 w = raw[r + k];
                  o[0] += cw[k][0][0] * bf_lo(w.x); o[1] += cw[k][0][1] * bf_hi(w.x); o[2] += cw[k][0][2] * bf_lo(w.y); o[3] += cw[k][0][3] * bf_hi(w.y);
                  o[4] += cw[k][1][0] * bf_lo(w.z); o[5] += cw[k][1][1] * bf_hi(w.z); o[6] += cw[k][1][2] * bf_lo(w.w); o[7] += cw[k][1][3] * bf_hi(w.w); }
              u32x4 p; p.x = cvt_pk_bf16(o[0], o[1]); p.y = cvt_pk_bf16(o[2], o[3]); p.z = cvt_pk_bf16(o[4], o[5]); p.w = cvt_pk_bf16(o[6], o[7]);
              *(LAS u32x4*)(lds + MB_XC + (8 * rg + r) * MB_XPITCH + 16 * cg) = p; } }
        if (step + 1 < SEQ / 128) {
#pragma unroll
            for (int i = 0; i < 11; ++i) raw[i] = *(const u32x4*)(xrp + (ptrdiff_t)(t0 + 128 + i - 3) * LW); }
        const size_t gb = (rowbase + 16 * rgp) * LW + OC + 8 * wave + c8;
        unsigned short yr[16];
#pragma unroll
        for (int i = 0; i < 16; ++i) yr[i] = GYR[gb + (size_t)i * LW];
        LDS_BARRIER();
        { f32x4 ca[4], cx[4];
#pragma unroll
          for (int m = 0; m < 4; ++m) { ca[m] = (f32x4){0.f, 0.f, 0.f, 0.f}; cx[m] = (f32x4){0.f, 0.f, 0.f, 0.f}; }
#pragma unroll
          for (int ks = 0; ks < 8; ++ks)
#pragma unroll
              for (int m = 0; m < 4; ++m) { const bf16x8 af = *(const LAS bf16x8*)(lds + MB_XC + (64 * rh + 16 * m + fr) * MB_XPITCH + (32 * ks + 8 * fq) * 2);
                  ca[m] = __builtin_amdgcn_mfma_f32_16x16x32_bf16(bfa[ks], af, ca[m], 0, 0, 0); cx[m] = __builtin_amdgcn_mfma_f32_16x16x32_bf16(bfx[ks], af, cx[m], 0, 0, 0); }
#pragma unroll
          for (int m = 0; m < 4; ++m) { const int r = 64 * rh + 16 * m + fr; const int cl = 16 * cb + 4 * fq;
              const u32x2 xw = *(const LAS u32x2*)(lds + MB_XC + r * MB_XPITCH + (64 * q + cl) * 2);
              const float xv[4] = {bf_lo(xw.x), bf_hi(xw.x), bf_lo(xw.y), bf_hi(xw.y)};
#pragma unroll
              for (int e = 0; e < 4; ++e) { const float rgt = sigmoid_f(ca[m][e] + ba[e]), ig = sigmoid_f(cx[m][e] + bx[e]);
                  const float la = rgt * sp[e]; const float av = __builtin_amdgcn_exp2f(1.4426950409f * la);
                  const float y = 2.0f * la;
                  const float om = (y > -0.0625f) ? -y * (1.0f + y * (0.5f + y * (0.16666667f + y * 0.041666668f))) : (1.0f - av * av);
                  ag[r * 65 + cl + e] = (f32x2){av, __builtin_amdgcn_sqrtf(om) * ig * xv[e]}; } } }
        LDS_BARRIER();
        { f32x2 v[16]; float P = 1.f, Hh = 0.f;
#pragma unroll
          for (int i = 0; i < 16; ++i) { v[i] = ag[(16 * rgp + i) * 65 + 8 * wave + c8]; Hh = v[i].x * Hh + v[i].y; P *= v[i].x; }
#pragma unroll
          for (int d = 8; d < 64; d <<= 1) { const float Pp = __shfl_up(P, d), Hp = __shfl_up(Hh, d); if (lane >= d) { Hh = P * Hp + Hh; P = P * Pp; } }
          const float Pe = __shfl_up(P, 8), He = __shfl_up(Hh, 8);
          float c = (rgp == 0) ? carry : (Pe * carry + He);
          const float Pt = __shfl(P, 56 + c8), Ht = __shfl(Hh, 56 + c8);
          carry = Pt * carry + Ht;
#pragma unroll
          for (int i = 0; i < 16; ++i) { c = v[i].x * c + v[i].y; const float y = c * __uint_as_float((unsigned)yr[i] << 16); YB[gb + (size_t)i * LW] = (bf16)(cvt_pk_bf16(y, 0.f) & 0xffffu); } }
    }
    __syncthreads();
}

__device__ __forceinline__ void p6_fixup(const Args& a, int vcu, int G) {
    const int gt = vcu * (NWAVES * 64) + opaque_tid(), NT = G * NWAVES * 64;
    unsigned char* ws = a.ws; const float* HEAD = (const float*)(ws + WS_HEAD); const float* TAIL = (const float*)(ws + WS_TAIL); bf16* Gb = (bf16*)(ws + WS_G);
    const float* cw = a.in[19]; const float* cbv = a.in[20];
    for (int item = gt; item < 32 * 96 * 128; item += NT) {
        const int jj = item & 127, t = item >> 7, pn = t % 96, pm = t / 96; const int c = 128 * pn + jj;
        const float* hb = HEAD + ((size_t)(pm * 96 + pn) * 2) * 256;
        const float h0g = hb[jj], h1g = hb[256 + jj], h0v = hb[128 + jj], h1v = hb[256 + 128 + jj];
        float t0g = 0.f, t1g = 0.f, t0v = 0.f, t1v = 0.f;
        if (pm & 7) { const float* tb = TAIL + ((size_t)((pm - 1) * 96 + pn) * 2) * 256; t0g = tb[jj]; t1g = tb[256 + jj]; t0v = tb[128 + jj]; t1v = tb[256 + 128 + jj]; }
        const float wg0 = cw[c], wg1 = cw[UPN + c], wg2 = cw[2 * UPN + c], wv0 = cw[FFW + c], wv1 = cw[UPN + FFW + c], wv2 = cw[2 * UPN + FFW + c], bg = cbv[c], bv = cbv[FFW + c];
        const float g0 = bg + wg0 * t0g + wg1 * t1g + wg2 * h0g, v0 = bv + wv0 * t0v + wv1 * t1v + wv2 * h0v;
        const float g1 = bg + wg0 * t1g + wg1 * h0g + wg2 * h1g, v1 = bv + wv0 * t1v + wv1 * h0v + wv2 * h1v;
        Gb[(size_t)(256 * pm) * FFW + c] = (bf16)(cvt_pk_bf16(gelu_tanh_f(g0) * v0, 0.f) & 0xffffu);
        Gb[(size_t)(256 * pm + 1) * FFW + c] = (bf16)(cvt_pk_bf16(gelu_tanh_f(g1) * v1, 0.f) & 0xffffu);
    }
}

__device__ __forceinline__ void p8_final(const Args& a, int vcu, int G) {
    const int tid = opaque_tid(), lane = tid & 63, gw = vcu * NWAVES + __builtin_amdgcn_readfirstlane(tid >> 6), NGW = G * NWAVES;
    const float* rss = (const float*)(a.ws + WS_CTL) + CW_RSS3; const f32x4* gf = (const f32x4*)a.in[22] + lane;
    for (int m = gw; m < M; m += NGW) { const float rs = 1.0f / sqrtf(rss[m] * (1.0f / DM) + EPS); f32x4* o = (f32x4*)(a.out + (size_t)m * DM) + lane;
#pragma unroll
        for (int j = 0; j < 16; ++j) { const f32x4 v = o[64 * j], g = gf[64 * j]; o[64 * j] = v * rs * g; } }
}

__global__ void __launch_bounds__(NWAVES * 64, 2) hyb_fwd(Args args) {
    extern __shared__ __attribute__((aligned(16))) unsigned char lds_raw[];
    LAS unsigned char* lds = (LAS unsigned char*)lds_raw;
    volatile LAS unsigned* MISC = (volatile LAS unsigned*)(lds + MISC_OFF);
    const int tid = threadIdx.x;
    const int G = gridDim.x; const int bx = blockIdx.x; const int vcu = (G % 8 == 0) ? (bx % 8) * (G / 8) + bx / 8 : bx;
    unsigned char* ws = args.ws;
    unsigned* ctl = (unsigned*)(ws + WS_CTL);
    for (int u = tid; u < (LDS_BYTES - MISC_OFF) / 4; u += NWAVES * 64) ((LAS unsigned*)(lds + MISC_OFF))[u] = 0u;
    __syncthreads();
    XcdBarrier bar; bar.bar = ctl + CW_BAR; bar.x = 0; bar.st = nullptr;
    if (N_LAUNCHES == 1) bar = xcd_barrier_post(ctl + CW_BAR, MISC + 8);
#define GRID_BAR() do { if (N_LAUNCHES == 1) xcd_barrier(bar); } while (0)
    const int lo = args.ph_lo, hi = args.ph_hi;
#ifndef PH_MASK
#define PH_MASK 0x1ff
#endif
#ifndef REP_PH
#define REP_PH -1
#endif
#define NREP(k) ((REP_PH == (k)) ? 2 : 1)
#define IN(k) (((PH_MASK >> (k)) & 1) && lo <= (k) && (k) < hi)
#define BOTH(k) (IN(k) && IN((k) + 1))
    float* fctl = (float*)ctl;

    if (IN(0)) { for (int rep = 0; rep < NREP(0); ++rep) p0_prologue(args, lds, vcu, G); if (BOTH(0)) GRID_BAR(); }

    if (IN(1)) {
        pg8::Gemm g{(const bf16*)(ws + WS_H), (const bf16*)(ws + WS_WIN), M, INC, DM}; pg8::StaticOrder S; S.init(M, INC, G, bx);
        pg8::EpiProj E{(bf16*)(ws + WS_GU), (bf16*)(ws + WS_GV), (bf16*)(ws + WS_XR), (bf16*)(ws + WS_GYR), (bf16*)(ws + WS_SGA), (bf16*)(ws + WS_SGB), fctl + CW_VSUM, fctl + CW_VSQ};
        pg8::gemm_phase<pg8::EpiProj, pg8::StaticOrder, PG8_ALIGN, PG8_SP2>(lds, g, S, E);
        if (NREP(1) == 2) { pg8::EpiProj E2 = E; E2.vsum = fctl + CW_DUMMY; E2.vsq = fctl + CW_DUMMY + M; pg8::gemm_phase<pg8::EpiProj, pg8::StaticOrder, PG8_ALIGN, PG8_SP2>(lds, g, S, E2); }
        if (BOTH(1)) GRID_BAR();
    }

    if (IN(2)) {
        for (int rep = 0; rep < NREP(20); ++rep) for (int u = bx; u < NB * LH * 4; u += G) mixer_b_unit(args, lds, u);
        for (int rep = 0; rep < NREP(21); ++rep) for (int u = bx; u < NB * (SEQ / CHUNK) * 8; u += G) mixer_a_unit(args, lds, u);
        if (BOTH(2)) GRID_BAR();
    }

    if (IN(3)) {
        pg8::Gemm g1{(const bf16*)(ws + WS_YB), (const bf16*)(ws + WS_PB), M, DM, LW};
        pg8::StaticOrder S; S.init(M, DM, G, bx);
        pg8::EpiMerge E{(const bf16*)(ws + WS_SGA), (const bf16*)(ws + WS_SGB), (bf16*)(ws + WS_MRG)};
        pg8::gemm_phase_dual<pg8::EpiMerge, pg8::StaticOrder>(lds, g1, (const bf16*)(ws + WS_YA), (const bf16*)(ws + WS_PA), SGW, S, E);
        if (NREP(3) == 2) pg8::gemm_phase_dual<pg8::EpiMerge, pg8::StaticOrder>(lds, g1, (const bf16*)(ws + WS_YA), (const bf16*)(ws + WS_PA), SGW, S, E);
        if (BOTH(3)) GRID_BAR();
    }

    if (IN(4)) {
        pg8::Gemm g{(const bf16*)(ws + WS_MRG), (const bf16*)(ws + WS_WOUT), M, DM, DM}; pg8::StaticOrder S; S.init(M, DM, G, bx);
        pg8::EpiOut E{args.in[0], (bf16*)(ws + WS_X1B), fctl + CW_RSS2};
        pg8::gemm_phase<pg8::EpiOut, pg8::StaticOrder, PG8_ALIGN, PG8_SP2>(lds, g, S, E);
        if (NREP(4) == 2) { pg8::EpiOut E2 = E; E2.rowss = fctl + CW_DUMMY; pg8::gemm_phase<pg8::EpiOut, pg8::StaticOrder, PG8_ALIGN, PG8_SP2>(lds, g, S, E2); }
        if (BOTH(4)) GRID_BAR();
    }

    if (IN(5)) {
        pg8::Gemm g{(const bf16*)(ws + WS_X1B), (const bf16*)(ws + WS_WUP), M, UPN, DM}; pg8::StaticOrder S; S.init(M, UPN, G, bx);
        pg8::EpiUpGate E{(bf16*)(ws + WS_G), fctl + CW_RSS2, args.in[19], args.in[20], (float*)(ws + WS_HEAD), (float*)(ws + WS_TAIL), (LAS float*)(lds + HALO_OFF)};
        pg8::gemm_phase<pg8::EpiUpGate, pg8::StaticOrder, PG8_ALIGN, PG8_SP2>(lds, g, S, E);
        if (NREP(5) == 2) pg8::gemm_phase<pg8::EpiUpGate, pg8::StaticOrder, PG8_ALIGN, PG8_SP2>(lds, g, S, E);
        if (BOTH(5)) GRID_BAR();
    }

    if (IN(6)) { for (int rep = 0; rep < NREP(6); ++rep) p6_fixup(args, vcu, G); if (BOTH(6)) GRID_BAR(); }

    if (IN(7)) {
        pg8::Gemm g{(const bf16*)(ws + WS_G), (const bf16*)(ws + WS_WDN), M, DM, FFW}; pg8::StaticOrder S; S.init(M, DM, G, bx);
        pg8::EpiDown E{(const bf16*)(ws + WS_X1B), args.out, fctl + CW_RSS3};
        pg8::gemm_phase<pg8::EpiDown, pg8::StaticOrder, PG8_ALIGN, PG8_SP2>(lds, g, S, E);
        if (NREP(7) == 2) { pg8::EpiDown E2 = E; E2.rowss = fctl + CW_DUMMY; pg8::gemm_phase<pg8::EpiDown, pg8::StaticOrder, PG8_ALIGN, PG8_SP2>(lds, g, S, E2); }
        if (BOTH(7)) GRID_BAR();
    }

    if (IN(8)) p8_final(args, vcu, G);
#undef IN
#undef BOTH
#undef GRID_BAR
}

extern "C" void kernel_launch(void* const* d_in, const int* in_sizes, int n_in, void* d_out, int out_size, void* d_ws, size_t ws_size, hipStream_t stream) {
    static int grid = 0;
    if (grid == 0) {
        if (n_in != 23 || out_size != M * DM || ws_size < WS_END) { fprintf(stderr, "kernel_launch: unexpected shapes (n_in %d, out %d, ws %zu)\n", n_in, out_size, ws_size); grid = -1; return; }
        int dev = 0, cus = 0, per_cu = 0;
        if (hipGetDevice(&dev) != hipSuccess || hipDeviceGetAttribute(&cus, hipDeviceAttributeMultiprocessorCount, dev) != hipSuccess) { grid = -1; return; }
        if (hipFuncSetAttribute((const void*)hyb_fwd, hipFuncAttributeMaxDynamicSharedMemorySize, LDS_BYTES) != hipSuccess) { fprintf(stderr, "kernel_launch: hipFuncSetAttribute failed\n"); grid = -1; return; }
        if (hipOccupancyMaxActiveBlocksPerMultiprocessor(&per_cu, (const void*)hyb_fwd, NWAVES * 64, LDS_BYTES) != hipSuccess || per_cu < 1) { fprintf(stderr, "kernel_launch: occupancy query says %d\n", per_cu); }
        (void)hipGetLastError();
        grid = cus;
    }
    if (grid < 0) return;
    (void)in_sizes;
    (void)hipMemsetAsync((char*)d_ws + WS_CTL, 0, CTL_ZERO_BYTES, stream);
    Args a{};
    for (int i = 0; i < 23; ++i) a.in[i] = (const float*)d_in[i];
    a.out = (float*)d_out; a.ws = (unsigned char*)d_ws;
    if (N_LAUNCHES == 1) { a.ph_lo = 0; a.ph_hi = NPH; hipLaunchKernelGGL(hyb_fwd, dim3(grid), dim3(NWAVES * 64), LDS_BYTES, stream, a); }
    else for (int p = 0; p < NPH; ++p) { a.ph_lo = p; a.ph_hi = p + 1; hipLaunchKernelGGL(hyb_fwd, dim3(grid), dim3(NWAVES * 64), LDS_BYTES, stream, a); }
}
```

```cpp
#include <hip/hip_runtime.h>
#include <cstdio>
#include <cstdint>

#ifndef MK_N_LAUNCHES
#define MK_N_LAUNCHES 1
#endif

namespace pg8 {
#define PG8_LAS __attribute__((address_space(3)))
typedef unsigned short bf16_t;
typedef short bf16x8 __attribute__((ext_vector_type(8)));
typedef float f32x4 __attribute__((ext_vector_type(4)));
typedef unsigned u32x4 __attribute__((ext_vector_type(4)));
typedef unsigned u32x2 __attribute__((ext_vector_type(2)));
constexpr int BM = 256, BK = 64, HALF = 128, HTB = HALF * BK * 2  , STAGE_BYTES = 8 * HTB, NXCD = 8, WGM = 8;

__host__ __device__ __forceinline__ int lds_byte(int r, int c) { const int st = (r >> 4) * 2 + (c >> 5), rr = r & 15, cc = c & 31, ob = rr * 64 + cc * 2; return st * 1024 + (ob ^ (((ob >> 9) & 1) << 5)); }
__host__ __device__ __forceinline__ void stage_rc(int b, int& R, int& C) { const int st = b / 1024, sb = b % 1024, swz = sb ^ (((sb >> 9) & 1) << 5); R = (st >> 1) * 16 + swz / 64; C = (st & 1) * 32 + (swz % 64) / 2; }
__host__ __device__ __forceinline__ int perm32(int rho) { const int n = rho >> 4, i = rho & 15; return 8 * (i >> 2) + 4 * n + (i & 3); }

struct Unit { int pm, pn; };
struct Gemm { const bf16_t* A; const bf16_t* Bt; int M, N, K; };

struct StaticOrder {
    int nM, nN, nwg, G, c;
    __host__ __device__ void init(int M, int N, int G_, int c_) { nM = M / BM; nN = N / BM; nwg = nM * nN; G = G_; c = c_; }
    __host__ __device__ bool next(int i, Unit& u) const {
        const long L = (long)i * G + c; if (L >= nwg) return false;
        int wgid = (int)L; { const int q = nwg / NXCD, r = nwg % NXCD, xcd = wgid % NXCD, off = wgid / NXCD; wgid = (xcd < r ? xcd * (q + 1) : r * (q + 1) + (xcd - r) * q) + off; }
        const int nig = WGM * nN, gid = wgid / nig, fm = gid * WGM, gsz = (nM - fm) < WGM ? (nM - fm) : WGM;
        u.pm = fm + ((wgid % nig) % gsz); u.pn = (wgid % nig) / gsz; return true;
    }
    __device__ __forceinline__ void a_ready(const Unit&) const {}
    __device__ __forceinline__ void done(const Unit&) const {}
};

__device__ __forceinline__ unsigned cvt_pk_bf16(float lo, float hi) { unsigned r; asm volatile("v_cvt_pk_bf16_f32 %0, %1, %2" : "=v"(r) : "v"(lo), "v"(hi)); return r; }
__device__ __forceinline__ float bf_lo(unsigned w) { return __uint_as_float(w << 16); }
__device__ __forceinline__ float bf_hi(unsigned w) { return __uint_as_float(w & 0xffff0000u); }
__device__ __forceinline__ float sigmoid_f(float z) { return __builtin_amdgcn_rcpf(1.0f + __builtin_amdgcn_exp2f(-1.4426950409f * z)); }
__device__ __forceinline__ float gelu_tanh_f(float v) { const float t = v * (-2.3022082f + -0.10294324f * v * v); return v * __builtin_amdgcn_rcpf(1.0f + __builtin_amdgcn_exp2f(t)); }


struct EpiProj {
    static constexpr bool PERM = true, AFTER_DRAIN = false, PERMA = false;
    bf16_t *GU, *GV, *XR, *GYR, *SGA, *SGB; float *vsum, *vsq;
    __device__ __forceinline__ void operator()(const f32x4 (&acc)[2][2][4][2], const Unit& u, int wr, int wc, int fr, int fq) const {
        const int pn = u.pn; bf16_t* base; int ldc, colt, act;
        if (pn < 8)       { base = GU;  ldc = 2048; colt = pn * 256;        act = 1; }
        else if (pn < 16) { base = GV;  ldc = 2048; colt = (pn - 8) * 256;  act = 1; }
        else if (pn < 32) { base = XR;  ldc = 4096; colt = (pn - 16) * 256; act = 0; }
        else if (pn < 48) { base = GYR; ldc = 4096; colt = (pn - 32) * 256; act = 1; }
        else if (pn < 64) { base = SGA; ldc = 4096; colt = (pn - 48) * 256; act = 2; }
        else              { base = SGB; ldc = 4096; colt = (pn - 64) * 256; act = 2; }
        const bool st = (pn >= 8) && (pn < 16);
        const int row0 = u.pm * BM + wr * 64 + fr, col0 = colt + wc * 32 + 8 * fq;
#pragma unroll
        for (int ai = 0; ai < 2; ++ai)
#pragma unroll
            for (int m = 0; m < 4; ++m) { const int row = row0 + ai * HALF + m * 16; bf16_t* rowp = base + (size_t)row * ldc + col0; float s = 0.f, q = 0.f;
#pragma unroll
                for (int bj = 0; bj < 2; ++bj) { f32x4 v0 = acc[ai][bj][m][0], v1 = acc[ai][bj][m][1];
                    if (act == 1) {
#pragma unroll
                        for (int j = 0; j < 4; ++j) { v0[j] = gelu_tanh_f(v0[j]); v1[j] = gelu_tanh_f(v1[j]); } }
                    else if (act == 2) {
#pragma unroll
                        for (int j = 0; j < 4; ++j) { v0[j] = sigmoid_f(v0[j]); v1[j] = sigmoid_f(v1[j]); } }
                    if (st) {
#pragma unroll
                        for (int j = 0; j < 4; ++j) { s += v0[j] + v1[j]; q += v0[j] * v0[j] + v1[j] * v1[j]; } }
                    u32x4 w; w.x = cvt_pk_bf16(v0[0], v0[1]); w.y = cvt_pk_bf16(v0[2], v0[3]); w.z = cvt_pk_bf16(v1[0], v1[1]); w.w = cvt_pk_bf16(v1[2], v1[3]);
                    *(u32x4*)(rowp + bj * HALF) = w; }
                if (st) { s += __shfl_xor(s, 16); s += __shfl_xor(s, 32); q += __shfl_xor(q, 16); q += __shfl_xor(q, 32);
                    if (fq == 0) { unsafeAtomicAdd(vsum + row, s); unsafeAtomicAdd(vsq + row, q); } } }
    }
};
struct EpiMerge {
    static constexpr bool PERM = true, AFTER_DRAIN = false, PERMA = false;
    const bf16_t* SGA; const bf16_t* SGB; bf16_t* O;
    __device__ __forceinline__ void mid(f32x4 (&acc)[2][2][4][2], const Unit& u, int wr, int wc, int fr, int fq) const {
        asm volatile("" : "+v"(fr), "+v"(fq));
        const int row0 = u.pm * BM + wr * 64 + fr, col0 = u.pn * BM + wc * 32 + 8 * fq;
#pragma unroll
        for (int ai = 0; ai < 2; ++ai)
#pragma unroll
            for (int m = 0; m < 4; ++m) { const size_t off = (size_t)(row0 + ai * HALF + m * 16) * 4096 + col0;
#pragma unroll
                for (int bj = 0; bj < 2; ++bj) { const u32x4 ga = *(const u32x4*)(SGA + off + bj * HALF), gb = *(const u32x4*)(SGB + off + bj * HALF);
                    const unsigned wa[4] = {ga.x, ga.y, ga.z, ga.w}, wb[4] = {gb.x, gb.y, gb.z, gb.w};
#pragma unroll
                    for (int p = 0; p < 4; ++p) { const float rl = bf_lo(wa[p]) * __builtin_amdgcn_rcpf(fmaxf(bf_lo(wb[p]), 1e-20f)), rh = bf_hi(wa[p]) * __builtin_amdgcn_rcpf(fmaxf(bf_hi(wb[p]), 1e-20f));
                        acc[ai][bj][m][p >> 1][(p & 1) * 2] *= rl; acc[ai][bj][m][p >> 1][(p & 1) * 2 + 1] *= rh; } }
                if (m == 3) asm volatile("" : "+v"(acc[ai][0][0][0]), "+v"(acc[ai][0][0][1]), "+v"(acc[ai][1][0][0]), "+v"(acc[ai][1][0][1]), "+v"(acc[ai][0][1][0]), "+v"(acc[ai][0][1][1]), "+v"(acc[ai][1][1][0]), "+v"(acc[ai][1][1][1]), "+v"(acc[ai][0][2][0]), "+v"(acc[ai][0][2][1]), "+v"(acc[ai][1][2][0]), "+v"(acc[ai][1][2][1]), "+v"(acc[ai][0][3][0]), "+v"(acc[ai][0][3][1]), "+v"(acc[ai][1][3][0]), "+v"(acc[ai][1][3][1]) :: "memory"); }
    }
    __device__ __forceinline__ void operator()(const f32x4 (&acc)[2][2][4][2], const Unit& u, int wr, int wc, int fr, int fq) const {
        const int row0 = u.pm * BM + wr * 64 + fr, col0 = u.pn * BM + wc * 32 + 8 * fq;
        const bf16_t* gp = SGB + (size_t)row0 * 4096 + col0;
        u32x4 gin[3][2];
#define EPI_LOAD(g) do { const bf16_t* p_ = gp + (size_t)(((g) >> 2) * HALF + ((g) & 3) * 16) * 4096; gin[(g) % 3][0] = *(const u32x4*)(p_); gin[(g) % 3][1] = *(const u32x4*)(p_ + HALF); } while (0)
        EPI_LOAD(0); EPI_LOAD(1);
#pragma unroll
        for (int gi = 0; gi < 8; ++gi) { const int ai = gi >> 2, m = gi & 3;
            if (gi + 2 < 8) EPI_LOAD(gi + 2);
            const size_t off = (size_t)(row0 + ai * HALF + m * 16) * 4096 + col0;
#pragma unroll
            for (int bj = 0; bj < 2; ++bj) { const u32x4 g = gin[gi % 3][bj]; const f32x4 a0 = acc[ai][bj][m][0], a1 = acc[ai][bj][m][1];
                u32x4 w; w.x = cvt_pk_bf16(a0[0] * fmaxf(bf_lo(g.x), 1e-20f), a0[1] * fmaxf(bf_hi(g.x), 1e-20f)); w.y = cvt_pk_bf16(a0[2] * fmaxf(bf_lo(g.y), 1e-20f), a0[3] * fmaxf(bf_hi(g.y), 1e-20f));
                w.z = cvt_pk_bf16(a1[0] * fmaxf(bf_lo(g.z), 1e-20f), a1[1] * fmaxf(bf_hi(g.z), 1e-20f)); w.w = cvt_pk_bf16(a1[2] * fmaxf(bf_lo(g.w), 1e-20f), a1[3] * fmaxf(bf_hi(g.w), 1e-20f));
                *(u32x4*)(O + off + bj * HALF) = w; } }
#undef EPI_LOAD
    }
};
struct EpiOut {
    static constexpr bool PERM = true, AFTER_DRAIN = false, PERMA = false;
    const float* XI; bf16_t* XB; float* rowss;
    __device__ __forceinline__ void operator()(const f32x4 (&acc)[2][2][4][2], const Unit& u, int wr, int wc, int fr, int fq) const {
        const int row0 = u.pm * BM + wr * 64 + fr, col0 = u.pn * BM + wc * 32 + 8 * fq;
        const float* xp = XI + (size_t)row0 * 4096 + col0;
        f32x4 xin[3][4];
#define EPI_LOAD(g) do { const float* p_ = xp + (size_t)(((g) >> 2) * HALF + ((g) & 3) * 16) * 4096; \
            xin[(g) % 3][0] = *(const f32x4*)(p_); xin[(g) % 3][1] = *(const f32x4*)(p_ + 4); xin[(g) % 3][2] = *(const f32x4*)(p_ + HALF); xin[(g) % 3][3] = *(const f32x4*)(p_ + HALF + 4); } while (0)
        EPI_LOAD(0); EPI_LOAD(1);
#pragma unroll
        for (int g = 0; g < 8; ++g) { const int ai = g >> 2, m = g & 3;
            if (g + 2 < 8) EPI_LOAD(g + 2);
            const int row = row0 + ai * HALF + m * 16; const size_t off = (size_t)row * 4096 + col0; float q = 0.f;
#pragma unroll
            for (int bj = 0; bj < 2; ++bj) { const f32x4 x0 = xin[g % 3][2 * bj] + acc[ai][bj][m][0], x1 = xin[g % 3][2 * bj + 1] + acc[ai][bj][m][1];
#pragma unroll
                for (int j = 0; j < 4; ++j) q += x0[j] * x0[j] + x1[j] * x1[j];
                u32x4 w; w.x = cvt_pk_bf16(x0[0], x0[1]); w.y = cvt_pk_bf16(x0[2], x0[3]); w.z = cvt_pk_bf16(x1[0], x1[1]); w.w = cvt_pk_bf16(x1[2], x1[3]);
                *(u32x4*)(XB + off + bj * HALF) = w; }
            q += __shfl_xor(q, 16); q += __shfl_xor(q, 32);
            if (fq == 0) unsafeAtomicAdd(rowss + row, q); }
#undef EPI_LOAD
    }
};
struct EpiDown {
    static constexpr bool PERM = true, AFTER_DRAIN = false, PERMA = false;
    const bf16_t* XI; float* XO; float* rowss;
    __device__ __forceinline__ void operator()(const f32x4 (&acc)[2][2][4][2], const Unit& u, int wr, int wc, int fr, int fq) const {
        const int row0 = u.pm * BM + wr * 64 + fr, col0 = u.pn * BM + wc * 32 + 8 * fq;
        const bf16_t* xp = XI + (size_t)row0 * 4096 + col0;
        u32x4 xin[3][2];
#define EPI_LOAD(g) do { const bf16_t* p_ = xp + (size_t)(((g) >> 2) * HALF + ((g) & 3) * 16) * 4096; xin[(g) % 3][0] = *(const u32x4*)(p_); xin[(g) % 3][1] = *(const u32x4*)(p_ + HALF); } while (0)
        EPI_LOAD(0); EPI_LOAD(1);
#pragma unroll
        for (int g = 0; g < 8; ++g) { const int ai = g >> 2, m = g & 3;
            if (g + 2 < 8) EPI_LOAD(g + 2);
            const int row = row0 + ai * HALF + m * 16; const size_t off = (size_t)row * 4096 + col0; float q = 0.f;
#pragma unroll
            for (int bj = 0; bj < 2; ++bj) { const u32x4 r = xin[g % 3][bj]; const f32x4 a0 = acc[ai][bj][m][0], a1 = acc[ai][bj][m][1];
                f32x4 x0, x1; x0[0] = bf_lo(r.x) + a0[0]; x0[1] = bf_hi(r.x) + a0[1]; x0[2] = bf_lo(r.y) + a0[2]; x0[3] = bf_hi(r.y) + a0[3];
                x1[0] = bf_lo(r.z) + a1[0]; x1[1] = bf_hi(r.z) + a1[1]; x1[2] = bf_lo(r.w) + a1[2]; x1[3] = bf_hi(r.w) + a1[3];
                *(f32x4*)(XO + off + bj * HALF) = x0; *(f32x4*)(XO + off + bj * HALF + 4) = x1;
#pragma unroll
                for (int j = 0; j < 4; ++j) q += x0[j] * x0[j] + x1[j] * x1[j]; }
            q += __shfl_xor(q, 16); q += __shfl_xor(q, 32);
            if (fq == 0) unsafeAtomicAdd(rowss + row, q); }
#undef EPI_LOAD
    }
};
__device__ __forceinline__ float dpp_shr1(float old, float x) { return __int_as_float(__builtin_amdgcn_update_dpp(__float_as_int(old), __float_as_int(x), 0x111, 0xf, 0xf, false)); }
__device__ __forceinline__ float gelu_mul(float g, float v) {
    const float t = g * (-2.3022082f + -0.10294324f * g * g);
    return g * v * __builtin_amdgcn_rcpf(1.0f + __builtin_amdgcn_exp2f(t)); }
struct EpiUpGate {
    static constexpr bool PERM = true, AFTER_DRAIN = false, PERMA = true;
    bf16_t* G; const float* rowss; const float* cw; const float* cb; float* HEAD; float* TAIL; PG8_LAS float* halo;
    __device__ __forceinline__ void operator()(f32x4 (&acc)[2][2][4][2], const Unit& u, int wr, int wc, int fr, int fq) const {
        const int row0 = u.pm * BM + wr * 64 + 4 * fr;
        const int cbase = u.pn * 128 + wc * 32 + 8 * fq;
        f32x4 wg[3], wv[3], bg, bv;
#pragma unroll
        for (int k = 0; k < 3; ++k) { wg[k] = *(const f32x4*)(cw + (size_t)k * 24576 + cbase); wv[k] = *(const f32x4*)(cw + (size_t)k * 24576 + 12288 + cbase); }
        bg = *(const f32x4*)(cb + cbase); bv = *(const f32x4*)(cb + 12288 + cbase);
#pragma unroll
        for (int ai = 0; ai < 2; ++ai) { const f32x4 q = *(const f32x4*)(rowss + row0 + ai * HALF);
#pragma unroll
            for (int m = 0; m < 4; ++m) { const float rs = 1.0f / sqrtf(q[m] * (1.0f / 4096.0f) + 1e-6f);
#pragma unroll
                for (int bj = 0; bj < 2; ++bj) { acc[ai][bj][m][0] *= rs; acc[ai][bj][m][1] *= rs; } } }
        const size_t tb = ((size_t)(u.pm * 96 + u.pn) * 2) * 256;
#pragma unroll
        for (int ai = 0; ai < 2; ++ai) { const int blk = 2 * ai + wr;
            if (fr == 15) {
#pragma unroll
                for (int bj = 0; bj < 2; ++bj)
#pragma unroll
                    for (int n = 0; n < 2; ++n)
#pragma unroll
                        for (int mm = 0; mm < 2; ++mm) { const f32x4 v = acc[ai][bj][2 + mm][n];
#pragma unroll
                            for (int e = 0; e < 4; ++e) halo[((blk * 4 + wc) * 4 + fq) * 32 + (bj * 8 + n * 4 + e) * 2 + mm] = v[e];
                            if (blk == 3) *(f32x4*)(TAIL + tb + (size_t)mm * 256 + bj * HALF + wc * 32 + 8 * fq + 4 * n) = v; } }
            if (blk == 0 && fr == 0) {
#pragma unroll
                for (int bj = 0; bj < 2; ++bj)
#pragma unroll
                    for (int n = 0; n < 2; ++n)
#pragma unroll
                        for (int mm = 0; mm < 2; ++mm) *(f32x4*)(HEAD + tb + (size_t)mm * 256 + bj * HALF + wc * 32 + 8 * fq + 4 * n) = acc[0][bj][mm][n]; } }
        asm volatile("s_waitcnt lgkmcnt(0)" ::: "memory"); __builtin_amdgcn_s_barrier(); asm volatile("" ::: "memory");
#pragma unroll
        for (int n = 0; n < 2; ++n) {
            if (n == 1) {
#pragma unroll
                for (int k = 0; k < 3; ++k) { wg[k] = *(const f32x4*)(cw + (size_t)k * 24576 + cbase + 4); wv[k] = *(const f32x4*)(cw + (size_t)k * 24576 + 12288 + cbase + 4); }
                bg = *(const f32x4*)(cb + cbase + 4); bv = *(const f32x4*)(cb + 12288 + cbase + 4); }
#pragma unroll
            for (int ai = 0; ai < 2; ++ai) { const int blk = 2 * ai + wr; const int pblk = blk > 0 ? blk - 1 : 0; const float hz = blk > 0 ? 1.0f : 0.0f;
                f32x4 q2[2], q3[2];
#pragma unroll
                for (int bj = 0; bj < 2; ++bj) {
                    const PG8_LAS f32x4* hp = (const PG8_LAS f32x4*)(halo + ((pblk * 4 + wc) * 4 + fq) * 32 + (bj * 8 + n * 4) * 2);
                    const f32x4 ha = hp[0] * hz, hb = hp[1] * hz;
                    q2[bj][0] = dpp_shr1(ha[0], acc[ai][bj][2][n][0]); q3[bj][0] = dpp_shr1(ha[1], acc[ai][bj][3][n][0]);
                    q2[bj][1] = dpp_shr1(ha[2], acc[ai][bj][2][n][1]); q3[bj][1] = dpp_shr1(ha[3], acc[ai][bj][3][n][1]);
                    q2[bj][2] = dpp_shr1(hb[0], acc[ai][bj][2][n][2]); q3[bj][2] = dpp_shr1(hb[1], acc[ai][bj][3][n][2]);
                    q2[bj][3] = dpp_shr1(hb[2], acc[ai][bj][2][n][3]); q3[bj][3] = dpp_shr1(hb[3], acc[ai][bj][3][n][3]); }
#pragma unroll
                for (int m = 0; m < 4; ++m) { const int row = row0 + ai * HALF + m;
                    const f32x4 s1g = (m == 0) ? q3[0] : acc[ai][0][m > 0 ? m - 1 : 0][n], s2g = (m == 0) ? q2[0] : (m == 1) ? q3[0] : acc[ai][0][m > 1 ? m - 2 : 0][n];
                    const f32x4 s1v = (m == 0) ? q3[1] : acc[ai][1][m > 0 ? m - 1 : 0][n], s2v = (m == 0) ? q2[1] : (m == 1) ? q3[1] : acc[ai][1][m > 1 ? m - 2 : 0][n];
                    const f32x4 cgt = bg + wg[0] * s2g + wg[1] * s1g + wg[2] * acc[ai][0][m][n], cvl = bv + wv[0] * s2v + wv[1] * s1v + wv[2] * acc[ai][1][m][n];
                    float o[4];
#pragma unroll
                    for (int e = 0; e < 4; ++e) o[e] = gelu_mul(cgt[e], cvl[e]);
                    u32x2 w; w.x = cvt_pk_bf16(o[0], o[1]); w.y = cvt_pk_bf16(o[2], o[3]);
                    *(u32x2*)(G + (size_t)row * 12288 + cbase + 4 * n) = w; } } }
    }
};

template <class Epi, class Sched, bool ALIGN_EPI = false, bool SP2 = false>
__device__ __forceinline__ void gemm_phase(PG8_LAS unsigned char* lds, const Gemm g, const Sched& S, const Epi& E) {
    int tid = threadIdx.x; asm volatile("" : "+v"(tid));
    const int wid = __builtin_amdgcn_readfirstlane(tid >> 6), lane = tid & 63, wr = wid >> 2, wc = wid & 3, fr = lane & 15, fq = lane >> 4;
    const int K = g.K, nt = K / BK;
    unsigned voffA[2], voffB[2];
#pragma unroll
    for (int i = 0; i < 2; ++i) { int R, C; stage_rc(tid * 16 + i * 8192, R, C); const int Rb = Epi::PERM ? ((R & ~31) + perm32(R & 31)) : R;
        const int Ra = Epi::PERMA ? ((R & 64) + 4 * (R & 15) + ((R >> 4) & 3)) : R;
        voffA[i] = (unsigned)(Ra * K + C) * 2u; voffB[i] = (unsigned)(Rb * K + C) * 2u; }
    const size_t kstep = (size_t)(BK * 2);
    const size_t hstep = (size_t)HALF * K * 2;
    const size_t tstep = 2 * hstep;
    const unsigned ldsw = (unsigned)wid * 1024u;
    const int aoff = lds_byte(wr * 64 + fr, fq * 8), boff = lds_byte(wc * 32 + fr, fq * 8);
#define PG8_SA(b, h) (((b) * 2 + (h)) * HTB)
#define PG8_SB(b, h) ((4 + (b) * 2 + (h)) * HTB)
#define PG8_STAGE(bufoff, gbase, voff) do { _Pragma("unroll") for (int _i = 0; _i < 2; ++_i) \
        __builtin_amdgcn_global_load_lds((const unsigned*)((const char*)(gbase) + (voff)[_i]), (PG8_LAS unsigned*)(lds + (bufoff) + ldsw + _i * 8192), 16, 0, 0); } while (0)
#define PG8_LDA(dst, b, h) do { _Pragma("unroll") for (int m = 0; m < 4; ++m) _Pragma("unroll") for (int k = 0; k < 2; ++k) dst[m][k] = *(const PG8_LAS bf16x8*)(lds + PG8_SA(b, h) + aoff + m * 2048 + k * 1024); } while (0)
#define PG8_LDB(dst, b, h) do { _Pragma("unroll") for (int n = 0; n < 2; ++n) _Pragma("unroll") for (int k = 0; k < 2; ++k) dst[n][k] = *(const PG8_LAS bf16x8*)(lds + PG8_SB(b, h) + boff + n * 2048 + k * 1024); } while (0)
#define PG8_MMA(ai, bj, At, Bt) do { __builtin_amdgcn_s_setprio(1); _Pragma("unroll") for (int m = 0; m < 4; ++m) _Pragma("unroll") for (int n = 0; n < 2; ++n) _Pragma("unroll") for (int k = 0; k < 2; ++k) \
        acc[ai][bj][m][n] = __builtin_amdgcn_mfma_f32_16x16x32_bf16(Bt[n][k], At[m][k], acc[ai][bj][m][n], 0, 0, 0); __builtin_amdgcn_s_setprio(0); } while (0)
#define PG8_WAIT_V(n) asm volatile("s_waitcnt vmcnt(" #n ")" ::: "memory")
#define PG8_WAIT_L(n) asm volatile("s_waitcnt lgkmcnt(" #n ")" ::: "memory")
#define PG8_BAR __builtin_amdgcn_s_barrier()
#define PG8_SCHED __builtin_amdgcn_sched_barrier(0)
    Unit cur, nxt; int ui = 0;
    if (!S.next(0, cur)) return;
    f32x4 acc[2][2][4][2];
#pragma unroll
    for (int a = 0; a < 2; ++a)
#pragma unroll
        for (int b = 0; b < 2; ++b)
#pragma unroll
            for (int m = 0; m < 4; ++m)
#pragma unroll
                for (int n = 0; n < 2; ++n) acc[a][b][m][n] = (f32x4){0.f, 0.f, 0.f, 0.f};
    bf16x8 At[4][2], B0[2][2], B1[2][2];
    const char* cA = (const char*)g.A + (size_t)cur.pm * tstep; const char* cB = (const char*)g.Bt + (size_t)cur.pn * tstep;
    S.a_ready(cur);
    if constexpr (SP2) {
        PG8_STAGE(PG8_SB(0, 0), cB, voffB); PG8_STAGE(PG8_SB(0, 1), cB + hstep, voffB); PG8_STAGE(PG8_SA(0, 0), cA, voffA); PG8_STAGE(PG8_SA(0, 1), cA + hstep, voffA);
        if (wr == 1) PG8_BAR;
        PG8_WAIT_V(2); PG8_BAR;
        PG8_STAGE(PG8_SB(1, 0), cB + kstep, voffB); PG8_STAGE(PG8_SA(1, 0), cA + kstep, voffA); PG8_STAGE(PG8_SB(1, 1), cB + hstep + kstep, voffB);
        PG8_WAIT_V(6); PG8_BAR;
    } else {
        PG8_STAGE(PG8_SB(0, 0), cB, voffB); PG8_STAGE(PG8_SA(0, 0), cA, voffA); PG8_STAGE(PG8_SB(0, 1), cB + hstep, voffB); PG8_STAGE(PG8_SA(0, 1), cA + hstep, voffA);
        if (wr == 1) PG8_BAR;
        PG8_WAIT_V(4); PG8_BAR;
        PG8_STAGE(PG8_SB(1, 0), cB + kstep, voffB); PG8_STAGE(PG8_SA(1, 0), cA + kstep, voffA); PG8_STAGE(PG8_SB(1, 1), cB + hstep + kstep, voffB);
        PG8_WAIT_V(6); PG8_BAR;
    }
    for (;;) {
        const bool has_next = S.next(ui + 1, nxt);
        const char* nA = has_next ? (const char*)g.A + (size_t)nxt.pm * tstep : cA; const char* nB = has_next ? (const char*)g.Bt + (size_t)nxt.pn * tstep : cB;
        for (int t = 0; t < nt; t += 2) {
            const bool last = (t == nt - 2);
            const char* a1 = cA + (size_t)(t + 1) * kstep;
            const char* a2 = last ? nA : cA + (size_t)(t + 2) * kstep; const char* b2 = last ? nB : cB + (size_t)(t + 2) * kstep;
            const char* a3 = a2 + kstep; const char* b3 = b2 + kstep;
            if (last && has_next) S.a_ready(nxt);
            if constexpr (SP2) {
            PG8_LDB(B0, 0, 0); PG8_LDB(B1, 0, 1); PG8_SCHED; PG8_LDA(At, 0, 0); PG8_STAGE(PG8_SA(1, 1), a1 + hstep, voffA);
            PG8_WAIT_V(8); PG8_WAIT_L(0); PG8_BAR; PG8_MMA(0, 0, At, B0); PG8_MMA(0, 1, At, B1); PG8_BAR; PG8_SCHED;
            PG8_LDA(At, 0, 1); PG8_STAGE(PG8_SB(0, 0), b2, voffB); PG8_STAGE(PG8_SB(0, 1), b2 + hstep, voffB); PG8_STAGE(PG8_SA(0, 0), a2, voffA);
            PG8_WAIT_V(8); PG8_WAIT_L(0); PG8_BAR; PG8_MMA(1, 0, At, B0); PG8_MMA(1, 1, At, B1); PG8_BAR; PG8_SCHED;
            PG8_LDB(B0, 1, 0); PG8_LDB(B1, 1, 1); PG8_SCHED; PG8_LDA(At, 1, 0); PG8_STAGE(PG8_SA(0, 1), a2 + hstep, voffA);
            PG8_WAIT_V(8); PG8_WAIT_L(0); PG8_BAR; PG8_MMA(0, 0, At, B0); PG8_MMA(0, 1, At, B1); PG8_BAR; PG8_SCHED;
            PG8_LDA(At, 1, 1); PG8_STAGE(PG8_SB(1, 0), b3, voffB); PG8_STAGE(PG8_SB(1, 1), b3 + hstep, voffB); PG8_STAGE(PG8_SA(1, 0), a3, voffA);
            PG8_WAIT_V(8); PG8_WAIT_L(0); PG8_BAR; PG8_MMA(1, 0, At, B0); PG8_MMA(1, 1, At, B1); PG8_BAR; PG8_SCHED;
            } else {
            PG8_LDB(B0, 0, 0); PG8_SCHED; PG8_LDA(At, 0, 0); PG8_STAGE(PG8_SA(1, 1), a1 + hstep, voffA);
            PG8_WAIT_L(8); PG8_BAR; PG8_WAIT_L(0); PG8_MMA(0, 0, At, B0); PG8_BAR; PG8_SCHED;
            PG8_LDB(B1, 0, 1); PG8_STAGE(PG8_SB(0, 0), b2, voffB);
            PG8_BAR; PG8_WAIT_L(0); PG8_MMA(0, 1, At, B1); PG8_BAR;
            PG8_LDA(At, 0, 1); PG8_STAGE(PG8_SA(0, 0), a2, voffA);
            PG8_BAR; PG8_WAIT_L(0); PG8_MMA(1, 0, At, B0); PG8_BAR; PG8_SCHED;
            PG8_STAGE(PG8_SB(0, 1), b2 + hstep, voffB);
            PG8_WAIT_V(6); PG8_BAR; PG8_MMA(1, 1, At, B1); PG8_BAR;
            PG8_LDB(B0, 1, 0); PG8_SCHED; PG8_LDA(At, 1, 0); PG8_STAGE(PG8_SA(0, 1), a2 + hstep, voffA);
            PG8_WAIT_L(8); PG8_BAR; PG8_WAIT_L(0); PG8_MMA(0, 0, At, B0); PG8_BAR; PG8_SCHED;
            PG8_LDB(B1, 1, 1); PG8_STAGE(PG8_SB(1, 0), b3, voffB);
            PG8_BAR; PG8_WAIT_L(0); PG8_MMA(0, 1, At, B1); PG8_BAR;
            PG8_LDA(At, 1, 1); PG8_STAGE(PG8_SA(1, 0), a3, voffA);
            PG8_BAR; PG8_WAIT_L(0); PG8_MMA(1, 0, At, B0); PG8_BAR; PG8_SCHED;
            PG8_STAGE(PG8_SB(1, 1), b3 + hstep, voffB);
            PG8_WAIT_V(6); PG8_BAR; PG8_MMA(1, 1, At, B1); PG8_BAR;
            }
        }
        if constexpr (ALIGN_EPI) { if (wr == 0) PG8_BAR; }
        E(acc, cur, wr, wc, fr, fq); S.done(cur);
        if (!has_next) break;
#pragma unroll
        for (int a = 0; a < 2; ++a)
#pragma unroll
            for (int b = 0; b < 2; ++b)
#pragma unroll
                for (int m = 0; m < 4; ++m)
#pragma unroll
                    for (int n = 0; n < 2; ++n) acc[a][b][m][n] = (f32x4){0.f, 0.f, 0.f, 0.f};
        cur = nxt; cA = nA; cB = nB; ++ui;
        if constexpr (ALIGN_EPI) { if (wr == 1) PG8_BAR; }
    }
    PG8_WAIT_V(0);
    if constexpr (!ALIGN_EPI) { if (wr == 0) PG8_BAR; }
    PG8_BAR;
#undef PG8_SA
#undef PG8_SB
#undef PG8_STAGE
#undef PG8_LDA
#undef PG8_LDB
#undef PG8_MMA
#undef PG8_WAIT_V
#undef PG8_WAIT_L
#undef PG8_BAR
#undef PG8_SCHED
}
template <class Epi, class Sched>
__device__ __forceinline__ void gemm_phase_dual(PG8_LAS unsigned char* lds, const Gemm g  , const bf16_t* A0, const bf16_t* Bt0, int K0, const Sched& S, const Epi& E) {
    int tid = threadIdx.x; asm volatile("" : "+v"(tid));
    const int wid = __builtin_amdgcn_readfirstlane(tid >> 6), lane = tid & 63, wr = wid >> 2, wc = wid & 3, fr = lane & 15, fq = lane >> 4;
    const int K = g.K;
    unsigned voffA[2], voffB[2];
#pragma unroll
    for (int i = 0; i < 2; ++i) { int R, C; stage_rc(tid * 16 + i * 8192, R, C); const int Rb = Epi::PERM ? ((R & ~31) + perm32(R & 31)) : R;
        voffA[i] = (unsigned)(R * K + C) * 2u; voffB[i] = (unsigned)(Rb * K + C) * 2u; }
    const size_t kstep = (size_t)(BK * 2);
    const size_t hstep = (size_t)HALF * K * 2;
    const size_t tstep = 2 * hstep;
    const unsigned ldsw = (unsigned)wid * 1024u;
    const int aoff = lds_byte(wr * 64 + fr, fq * 8), boff = lds_byte(wc * 32 + fr, fq * 8);
#define PG8_SA(b, h) (((b) * 2 + (h)) * HTB)
#define PG8_SB(b, h) ((4 + (b) * 2 + (h)) * HTB)
#define PG8_STAGE(bufoff, gbase, voff) do { _Pragma("unroll") for (int _i = 0; _i < 2; ++_i) \
        __builtin_amdgcn_global_load_lds((const unsigned*)((const char*)(gbase) + (voff)[_i]), (PG8_LAS unsigned*)(lds + (bufoff) + ldsw + _i * 8192), 16, 0, 0); } while (0)
#define PG8_LDA(dst, b, h) do { _Pragma("unroll") for (int m = 0; m < 4; ++m) _Pragma("unroll") for (int k = 0; k < 2; ++k) dst[m][k] = *(const PG8_LAS bf16x8*)(lds + PG8_SA(b, h) + aoff + m * 2048 + k * 1024); } while (0)
#define PG8_LDB(dst, b, h) do { _Pragma("unroll") for (int n = 0; n < 2; ++n) _Pragma("unroll") for (int k = 0; k < 2; ++k) dst[n][k] = *(const PG8_LAS bf16x8*)(lds + PG8_SB(b, h) + boff + n * 2048 + k * 1024); } while (0)
#define PG8_MMA(ai, bj, At, Bt) do { __builtin_amdgcn_s_setprio(1); _Pragma("unroll") for (int m = 0; m < 4; ++m) _Pragma("unroll") for (int n = 0; n < 2; ++n) _Pragma("unroll") for (int k = 0; k < 2; ++k) \
        acc[ai][bj][m][n] = __builtin_amdgcn_mfma_f32_16x16x32_bf16(Bt[n][k], At[m][k], acc[ai][bj][m][n], 0, 0, 0); __builtin_amdgcn_s_setprio(0); } while (0)
#define PG8_WAIT_V(n) asm volatile("s_waitcnt vmcnt(" #n ")" ::: "memory")
#define PG8_WAIT_L(n) asm volatile("s_waitcnt lgkmcnt(" #n ")" ::: "memory")
#define PG8_BAR __builtin_amdgcn_s_barrier()
#define PG8_SCHED __builtin_amdgcn_sched_barrier(0)
    Unit cur, nxt; int ui = 0;
    if (!S.next(0, cur)) return;
    f32x4 acc[2][2][4][2];
#pragma unroll
    for (int a = 0; a < 2; ++a)
#pragma unroll
        for (int b = 0; b < 2; ++b)
#pragma unroll
            for (int m = 0; m < 4; ++m)
#pragma unroll
                for (int n = 0; n < 2; ++n) acc[a][b][m][n] = (f32x4){0.f, 0.f, 0.f, 0.f};
    bf16x8 At[4][2], B0[2][2], B1[2][2];
    const char* cA = (const char*)A0 + (size_t)cur.pm * tstep; const char* cB = (const char*)Bt0 + (size_t)cur.pn * tstep;
    PG8_STAGE(PG8_SB(0, 0), cB, voffB); PG8_STAGE(PG8_SB(0, 1), cB + hstep, voffB); PG8_STAGE(PG8_SA(0, 0), cA, voffA); PG8_STAGE(PG8_SA(0, 1), cA + hstep, voffA);
    if (wr == 1) PG8_BAR;
    PG8_WAIT_V(2); PG8_BAR;
    PG8_STAGE(PG8_SB(1, 0), cB + kstep, voffB); PG8_STAGE(PG8_SA(1, 0), cA + kstep, voffA); PG8_STAGE(PG8_SB(1, 1), cB + hstep + kstep, voffB);
    PG8_WAIT_V(6); PG8_BAR;
#define PG8_KLOOP(NT, CA, CB, NA, NB) for (int t = 0; t < (NT); t += 2) { \
            const bool last = (t == (NT) - 2); \
            const char* a1 = (CA) + (size_t)(t + 1) * kstep; \
            const char* a2 = last ? (NA) : (CA) + (size_t)(t + 2) * kstep; const char* b2 = last ? (NB) : (CB) + (size_t)(t + 2) * kstep; \
            const char* a3 = a2 + kstep; const char* b3 = b2 + kstep; \
            PG8_LDB(B0, 0, 0); PG8_LDB(B1, 0, 1); PG8_SCHED; PG8_LDA(At, 0, 0); PG8_STAGE(PG8_SA(1, 1), a1 + hstep, voffA); \
            PG8_WAIT_V(8); PG8_WAIT_L(0); PG8_BAR; PG8_MMA(0, 0, At, B0); PG8_MMA(0, 1, At, B1); PG8_BAR; PG8_SCHED; \
            PG8_LDA(At, 0, 1); PG8_STAGE(PG8_SB(0, 0), b2, voffB); PG8_STAGE(PG8_SB(0, 1), b2 + hstep, voffB); PG8_STAGE(PG8_SA(0, 0), a2, voffA); \
            PG8_WAIT_V(8); PG8_WAIT_L(0); PG8_BAR; PG8_MMA(1, 0, At, B0); PG8_MMA(1, 1, At, B1); PG8_BAR; PG8_SCHED; \
            PG8_LDB(B0, 1, 0); PG8_LDB(B1, 1, 1); PG8_SCHED; PG8_LDA(At, 1, 0); PG8_STAGE(PG8_SA(0, 1), a2 + hstep, voffA); \
            PG8_WAIT_V(8); PG8_WAIT_L(0); PG8_BAR; PG8_MMA(0, 0, At, B0); PG8_MMA(0, 1, At, B1); PG8_BAR; PG8_SCHED; \
            PG8_LDA(At, 1, 1); PG8_STAGE(PG8_SB(1, 0), b3, voffB); PG8_STAGE(PG8_SB(1, 1), b3 + hstep, voffB); PG8_STAGE(PG8_SA(1, 0), a3, voffA); \
            PG8_WAIT_V(8); PG8_WAIT_L(0); PG8_BAR; PG8_MMA(1, 0, At, B0); PG8_MMA(1, 1, At, B1); PG8_BAR; PG8_SCHED; }
    const int nt0 = K0 / BK, nt1 = K / BK;
    for (;;) {
        const char* mA = (const char*)g.A + (size_t)cur.pm * tstep; const char* mB = (const char*)g.Bt + (size_t)cur.pn * tstep;
        PG8_KLOOP(nt0, cA, cB, mA, mB)
        E.mid(acc, cur, wr, wc, fr, fq);
        const bool has_next = S.next(ui + 1, nxt);
        const char* nA = has_next ? (const char*)A0 + (size_t)nxt.pm * tstep : mA; const char* nB = has_next ? (const char*)Bt0 + (size_t)nxt.pn * tstep : mB;
        PG8_KLOOP(nt1, mA, mB, nA, nB)
        if (wr == 0) PG8_BAR;
        E(acc, cur, wr, wc, fr, fq);
        if (!has_next) break;
#pragma unroll
        for (int a = 0; a < 2; ++a)
#pragma unroll
            for (int b = 0; b < 2; ++b)
#pragma unroll
                for (int m = 0; m < 4; ++m)
#pragma unroll
                    for (int n = 0; n < 2; ++n) acc[a][b][m][n] = (f32x4){0.f, 0.f, 0.f, 0.f};
        cur = nxt; cA = nA; cB = nB; ++ui;
        if (wr == 1) PG8_BAR;
    }
#undef PG8_KLOOP
    PG8_WAIT_V(0);
    PG8_BAR;
#undef PG8_SA
#undef PG8_SB
#undef PG8_STAGE
#undef PG8_LDA
#undef PG8_LDB
#undef PG8_MMA
#undef PG8_WAIT_V
#undef PG8_WAIT_L
#undef PG8_BAR
#undef PG8_SCHED
}
}


#ifndef PG8_SP2
#define PG8_SP2 true
#endif
#ifndef PG8_ALIGN
#define PG8_ALIGN true
#endif

constexpr int NWAVES = 8;
constexpr int N_LAUNCHES = MK_N_LAUNCHES;
constexpr int NPH = 9;
constexpr int DM = 4096, SEQ = 2048, NB = 4, M = NB * SEQ;
constexpr int SGW = 2048, SGD = 256, CHUNK = 128;
constexpr int LW = 4096, LH = 16, LHD = 256;
constexpr int FFW = 12288, UPN = 2 * FFW, INC = 20480;
constexpr float EPS = 1e-6f;

constexpr size_t MiB = 1u << 20;
constexpr size_t WS_CTL = 0, CTL_ZERO_BYTES = 1 * MiB;
constexpr size_t WS_WIN = 2 * MiB, WS_WUP = 162 * MiB, WS_WDN = 354 * MiB, WS_PA = 450 * MiB, WS_PB = 482 * MiB, WS_WOUT = 514 * MiB, WS_WA = 546 * MiB, WS_WX = 548 * MiB;
constexpr size_t WS_H = 552 * MiB, WS_GU = 616 * MiB, WS_GV = 648 * MiB, WS_XR = 680 * MiB, WS_GYR = 744 * MiB, WS_SGA = 808 * MiB, WS_SGB = 872 * MiB;
constexpr size_t WS_YA = 936 * MiB  , WS_YB = 1000 * MiB, WS_MRG = 1064 * MiB, WS_X1B = 1128 * MiB, WS_END = 1192 * MiB;
constexpr size_t WS_HEAD = 552 * MiB, WS_TAIL = 560 * MiB;
constexpr size_t WS_G = 616 * MiB;
static_assert(WS_TAIL + (size_t)32 * 96 * 2 * 256 * 4 <= WS_GU && WS_G + (size_t)M * FFW * 2 <= WS_SGA, "overlay map");
constexpr int CW_TMO = 0;
constexpr int CW_BAR = 4096;
constexpr int CW_VSUM = 16384, CW_VSQ = CW_VSUM + M, CW_RSS2 = CW_VSQ + M, CW_RSS3 = CW_RSS2 + M, CW_DUMMY = CW_RSS3 + M;
static_assert((CW_DUMMY + 2 * M) * 4 <= (int)CTL_ZERO_BYTES, "CTL words inside the memset region");

constexpr int LDS_BYTES = 155648;
constexpr int MISC_OFF = 154624;
constexpr int HALO_OFF = 131072;

#define LAS __attribute__((address_space(3)))
typedef unsigned short bf16;
typedef float f32x4 __attribute__((ext_vector_type(4)));
typedef unsigned u32x4 __attribute__((ext_vector_type(4)));
typedef unsigned u32x2 __attribute__((ext_vector_type(2)));
typedef short bf16x8 __attribute__((ext_vector_type(8)));
#define LDS_WAIT() asm volatile("s_waitcnt lgkmcnt(0)" ::: "memory")
#define VM_WAIT() asm volatile("s_waitcnt vmcnt(0)" ::: "memory")
#define LDS_BARRIER() do { asm volatile("s_waitcnt lgkmcnt(0)" ::: "memory"); __builtin_amdgcn_s_barrier(); asm volatile("" ::: "memory"); } while (0)
using pg8::cvt_pk_bf16; using pg8::bf_lo; using pg8::bf_hi; using pg8::sigmoid_f; using pg8::gelu_tanh_f;

#define XB_TMO      128
#define XB_XCNT(j)  (256  + 64 * (j))
#define XB_XSUB(j)  (1280 + 64 * (j))
#define XB_XGEN(j)  (2304 + 64 * (j))
#define XB_TOP      3328
#define XB_TOPGEN   3392
#define XCD_BAR_WORDS 3456
#define XB_SPIN_CAP (1u << 18)
__device__ __forceinline__ unsigned xb_ld(unsigned* p)              { return __hip_atomic_load(p, __ATOMIC_RELAXED, __HIP_MEMORY_SCOPE_AGENT); }
__device__ __forceinline__ unsigned xb_add(unsigned* p, unsigned v) { return __hip_atomic_fetch_add(p, v, __ATOMIC_RELAXED, __HIP_MEMORY_SCOPE_AGENT); }
__device__ __forceinline__ unsigned xb_xcc_id() { return (unsigned)__builtin_amdgcn_s_getreg((3 << 11) | 20) & 0xFu; }
#define XB_SPIN(cond, bar) do { unsigned _sp = 0; while (cond) { __builtin_amdgcn_s_sleep(1); \
    if ((++_sp & 255u) == 0u) { if (xb_ld(&(bar)[XB_TMO])) break; if (_sp > XB_SPIN_CAP) { atomicAdd(&(bar)[XB_TMO], 1u); break; } } } } while (0)
struct XcdBarrier { unsigned* bar; unsigned x; volatile LAS unsigned* st; };
__device__ __forceinline__ XcdBarrier xcd_barrier_post(unsigned* bar, volatile LAS unsigned* st) {
    XcdBarrier b; b.bar = bar; b.x = xb_xcc_id(); b.st = st;
    if (threadIdx.x == 0) (void)xb_add(&bar[XB_XCNT(b.x)], 1u);
    return b;
}
__device__ __forceinline__ void xcd_barrier_complete(unsigned* bar, unsigned x, unsigned& nloc, unsigned& nx) {
    const unsigned G = gridDim.x * gridDim.y * gridDim.z;
    unsigned sum, cnt, mine, sp = 0u;
    for (;;) {
        sum = 0u; cnt = 0u; mine = 0u;
#pragma unroll
        for (unsigned j = 0; j < 16; ++j) { const unsigned c = xb_ld(&bar[XB_XCNT(j)]); sum += c; cnt += (c > 0u) ? 1u : 0u; mine = (j == x) ? c : mine; }
        if (sum == G) break;
        __builtin_amdgcn_s_sleep(1);
        if ((++sp & 255u) == 0u) { if (xb_ld(&bar[XB_TMO])) break; if (sp > XB_SPIN_CAP) { atomicAdd(&bar[XB_TMO], 1u); break; } }
    }
    nloc = mine > 0u ? mine : 1u; nx = cnt > 0u ? cnt : 1u;
}
__device__ __forceinline__ void xcd_barrier(const XcdBarrier& b) {
    asm volatile("s_waitcnt vmcnt(0)" ::: "memory");
    __syncthreads();
    if (threadIdx.x == 0) {
        unsigned* bar = b.bar;
        __builtin_amdgcn_s_waitcnt(0);
        unsigned nloc = b.st[0], nx = b.st[1];
        if (nloc == 0u) { xcd_barrier_complete(bar, b.x, nloc, nx); b.st[0] = nloc; b.st[1] = nx; }
        const unsigned old = xb_add(&bar[XB_XSUB(b.x)], 1u);
        const unsigned gen = old / nloc;
        if (old + 1u == (gen + 1u) * nloc) {
            __builtin_amdgcn_fence(__ATOMIC_RELEASE, "agent");
            asm volatile("s_waitcnt vmcnt(0)" ::: "memory");
            const unsigned og = xb_add(&bar[XB_TOP], 1u);
            const unsigned tg = og / nx;
            if (og + 1u == (tg + 1u) * nx) xb_add(&bar[XB_TOPGEN], 1u);
            else XB_SPIN(xb_ld(&bar[XB_TOPGEN]) == tg, bar);
            __builtin_amdgcn_fence(__ATOMIC_ACQUIRE, "agent");
            xb_add(&bar[XB_XGEN(b.x)], 1u);
            asm volatile("s_waitcnt vmcnt(0)" ::: "memory");
        } else {
            XB_SPIN(xb_ld(&bar[XB_XGEN(b.x)]) == gen, bar);
            __builtin_amdgcn_fence(__ATOMIC_ACQUIRE, "agent");
            asm volatile("s_waitcnt vmcnt(0)" ::: "memory");
        }
    }
    __syncthreads();
}

__device__ __forceinline__ int opaque_tid() { int t = threadIdx.x; asm volatile("" : "+v"(t)); return t; }
__device__ __forceinline__ float wave_sum(float v) {
#pragma unroll
    for (int o = 1; o < 64; o <<= 1) v += __shfl_xor(v, o);
    return v;
}
__device__ __forceinline__ void tr_tile(const float* __restrict__ W, int ldw, bf16* __restrict__ WT, int ldt, int k0, int n0, int dn0, const float* __restrict__ gain, LAS unsigned* scr, int lane) {
    const int nl = (lane & 15) * 4, kq = lane >> 4;
    f32x4 v[16];
#pragma unroll
    for (int i = 0; i < 8; ++i)
#pragma unroll
        for (int h = 0; h < 2; ++h) v[2 * i + h] = __builtin_nontemporal_load((const f32x4*)(W + (size_t)(k0 + 8 * i + 2 * kq + h) * ldw + n0 + nl));
    if (gain) {
        const float gl = gain[k0 + lane];
#pragma unroll
        for (int i = 0; i < 8; ++i)
#pragma unroll
            for (int h = 0; h < 2; ++h) v[2 * i + h] *= __shfl(gl, 8 * i + 2 * kq + h); }
#pragma unroll
    for (int i = 0; i < 8; ++i)
#pragma unroll
        for (int j = 0; j < 4; ++j) scr[(nl + j) * 33 + 4 * i + kq] = cvt_pk_bf16(v[2 * i][j], v[2 * i + 1][j]);
    LDS_WAIT(); asm volatile("" ::: "memory");
    const int c = lane & 7, nr = lane >> 3;
#pragma unroll
    for (int it = 0; it < 8; ++it) { const int n = 8 * it + nr; const LAS unsigned* s = scr + n * 33 + 4 * c;
        u32x4 o; o.x = s[0]; o.y = s[1]; o.z = s[2]; o.w = s[3];
        *(u32x4*)(WT + (size_t)(dn0 + n) * ldt + k0 + 8 * c) = o; }
    LDS_WAIT(); asm volatile("" ::: "memory");
}

struct Args { const float* in[23]; float* out; unsigned char* ws; int ph_lo, ph_hi; };

constexpr int CV_UP = (DM / 32) * (UPN / 32), CV_DN = (FFW / 32) * (DM / 32), CV_PA = (SGW / 32) * (DM / 32), CV_PB = (LW / 32) * (DM / 32), CV_WO = (DM / 32) * (DM / 32);
constexpr int CV_TILES = CV_UP + CV_PB + CV_WO;
constexpr int MBT = 64, MB_STEPS = SEQ / MBT, CV_SLOTS = 2;
static_assert(CV_TILES <= NB * LH * 4 * MB_STEPS * NWAVES * CV_SLOTS, "every tile has a slot");
struct CvtTile { const float* src; bf16* dst; const float* gain; int ldw, ldt, valid, has_gain; };
__device__ __forceinline__ CvtTile cvt_decode(const Args& a, int t) {
    CvtTile c; c.src = a.in[18]; c.dst = nullptr; c.gain = a.in[17]; c.ldw = 0; c.ldt = 0; c.valid = 0; c.has_gain = 0;
    if (t < CV_UP) { const int kb = t % (DM / 32), nb = t / (DM / 32); const int n0 = 32 * nb; const int ch = (n0 < FFW) ? n0 : n0 - FFW; const int dn0 = (ch >> 7) * 256 + (ch & 127) + ((n0 < FFW) ? 0 : 128);
        c.src = a.in[18] + (size_t)(32 * kb) * UPN + n0; c.dst = (bf16*)(a.ws + WS_WUP) + (size_t)dn0 * DM + 32 * kb; c.gain = a.in[17] + 32 * kb; c.ldw = UPN; c.ldt = DM; c.valid = 1; c.has_gain = 1; return c; }
    const float* W; bf16* WT; int KB, N, K;
    if ((t -= CV_UP) < CV_PB) { W = a.in[15]; WT = (bf16*)(a.ws + WS_PB); KB = LW / 32; N = DM; K = LW; }
    else if ((t -= CV_PB) < CV_WO) { W = a.in[16]; WT = (bf16*)(a.ws + WS_WOUT); KB = DM / 32; N = DM; K = DM; }
    else return c;
    const int kb = t % KB, nb = t / KB;
    c.src = W + (size_t)(32 * kb) * N + 32 * nb; c.dst = WT + (size_t)(32 * nb) * K + 32 * kb; c.ldw = N; c.ldt = K; c.valid = 1; return c;
}
__device__ __forceinline__ void cvt_issue(const CvtTile& c, f32x4 (&v)[4], float& gl, int lane) {
    const float* p = c.src + (size_t)(2 * (lane >> 3)) * c.ldw + 4 * (lane & 7);
#pragma unroll
    for (int i = 0; i < 2; ++i)
#pragma unroll
        for (int h = 0; h < 2; ++h) v[2 * i + h] = __builtin_nontemporal_load((const f32x4*)(p + (size_t)(16 * i + h) * c.ldw));
    gl = c.gain[lane & 31];
}
__device__ __forceinline__ void cvt_finish(const CvtTile& c, const f32x4 (&v)[4], float gl, LAS unsigned* scr, int lane) {
    if (c.valid) { const int n4 = 4 * (lane & 7), kq = lane >> 3; gl = c.has_gain ? gl : 1.0f;
#pragma unroll
        for (int i = 0; i < 2; ++i) { const float g0 = __shfl(gl, 2 * kq + 16 * i), g1 = __shfl(gl, 2 * kq + 16 * i + 1);
#pragma unroll
            for (int j = 0; j < 4; ++j) scr[(n4 + j) * 17 + kq + 8 * i] = cvt_pk_bf16(v[2 * i][j] * g0, v[2 * i + 1][j] * g1); }
        LDS_WAIT(); asm volatile("" ::: "memory");
        const int cc = lane & 3, nr = lane >> 2;
#pragma unroll
        for (int it = 0; it < 2; ++it) { const int n = nr + 16 * it; const LAS unsigned* sp_ = scr + n * 17 + 4 * cc;
            u32x4 o; o.x = sp_[0]; o.y = sp_[1]; o.z = sp_[2]; o.w = sp_[3];
            *(u32x4*)(c.dst + (size_t)n * c.ldt + 8 * cc) = o; }
        LDS_WAIT(); asm volatile("" ::: "memory"); }
}

__device__ __forceinline__ void p0_prologue(const Args& a, LAS unsigned char* lds, int vcu, int G) {
    const int tid = opaque_tid(), lane = tid & 63, wave = __builtin_amdgcn_readfirstlane(tid >> 6);
    unsigned char* ws = a.ws;
    LAS unsigned* scr = (LAS unsigned*)(lds + wave * 8448);
    const int gw = vcu * NWAVES + wave, NGW = G * NWAVES;
    constexpr int T_IN = (DM / 64) * (INC / 64), T_DN = (FFW / 64) * (DM / 64), T_PA = (SGW / 64) * (DM / 64), T_G = LH * 16;
    constexpr int NT = T_IN + T_DN + T_PA + 2 * T_G;
    for (int it = gw; it < NT; it += NGW) {
        int r = it;
        if (r < T_IN) { const int nb = INC / 64; tr_tile(a.in[2], INC, (bf16*)(ws + WS_WIN), DM, 64 * (r / nb), 64 * (r % nb), 64 * (r % nb), nullptr, scr, lane); continue; } r -= T_IN;
        if (r < T_DN) { const int nb = DM / 64; tr_tile(a.in[21], DM, (bf16*)(ws + WS_WDN), FFW, 64 * (r / nb), 64 * (r % nb), 64 * (r % nb), nullptr, scr, lane); continue; } r -= T_DN;
        if (r < T_PA) { const int nb = DM / 64; tr_tile(a.in[14], DM, (bf16*)(ws + WS_PA), LW  , 64 * (r / nb), 64 * (r % nb), 64 * (r % nb), nullptr, scr, lane); continue; } r -= T_PA;
        if (r < T_G) { const int hd = r >> 4, t = r & 15; tr_tile(a.in[9] + (size_t)hd * LHD * LHD, LHD, (bf16*)(ws + WS_WA) + (size_t)hd * LHD * LHD, LHD, 64 * (t >> 2), 64 * (t & 3), 64 * (t & 3), nullptr, scr, lane); continue; } r -= T_G;
        { const int hd = r >> 4, t = r & 15; tr_tile(a.in[11] + (size_t)hd * LHD * LHD, LHD, (bf16*)(ws + WS_WX) + (size_t)hd * LHD * LHD, LHD, 64 * (t >> 2), 64 * (t & 3), 64 * (t & 3), nullptr, scr, lane); }
    }
    const float* x = a.in[0]; const f32x4* gm = (const f32x4*)a.in[1] + lane; bf16* H = (bf16*)(ws + WS_H);
    for (int m = gw; m < M; m += NGW) {
        const f32x4* xr = (const f32x4*)(x + (size_t)m * DM) + lane; f32x4 v[16]; float s = 0.f;
#pragma unroll
        for (int j = 0; j < 16; ++j) { v[j] = xr[64 * j]; s += (v[j][0] * v[j][0] + v[j][1] * v[j][1]) + (v[j][2] * v[j][2] + v[j][3] * v[j][3]); }
        const float rs = 1.0f / sqrtf(wave_sum(s) * (1.0f / DM) + EPS);
        u32x2* o = (u32x2*)(H + (size_t)m * DM) + lane;
#pragma unroll
        for (int j = 0; j < 16; ++j) { const f32x4 g = gm[64 * j]; u32x2 w; w.x = cvt_pk_bf16(v[j][0] * rs * g[0], v[j][1] * rs * g[1]); w.y = cvt_pk_bf16(v[j][2] * rs * g[2], v[j][3] * rs * g[3]); o[64 * j] = w; }
    }
}

constexpr int MA_PITCH = 272;
constexpr int MA_WT = 0, MA_VN = 128 * MA_PITCH;
__device__ __forceinline__ void mixer_a_unit(const Args& a, LAS unsigned char* lds, int unit) {
    const int tid = opaque_tid(), lane = tid & 63, wave = __builtin_amdgcn_readfirstlane(tid >> 6);
    unsigned char* ws = a.ws;
    const int g = unit & 7, bc = unit >> 3;
    const int R0 = bc * CHUNK, C0 = g * SGD;
    const bf16* GU = (const bf16*)(ws + WS_GU); const bf16* GV = (const bf16*)(ws + WS_GV); bf16* YA = (bf16*)(ws + WS_YA);
    const float* vsum = (const float*)(ws + WS_CTL) + CW_VSUM; const float* vsq = (const float*)(ws + WS_CTL) + CW_VSQ;
    const int t_ = tid >> 2, sq = tid & 3; const float* src = a.in[5] + ((size_t)g * CHUNK + t_) * CHUNK + 32 * sq;
    f32x4 wraw[8];
#pragma unroll
    for (int i = 0; i < 8; ++i) wraw[i] = *(const f32x4*)(src + 4 * i);
    const int s0l = 2 * lane; const int r0 = R0 + s0l;
    const float vs0 = vsum[r0], vs1 = vsum[r0 + 1], vq0 = vsq[r0], vq1 = vsq[r0 + 1];
    u32x4 gq[4][2];
#pragma unroll
    for (int it = 0; it < 4; ++it) { const int col = C0 + 8 * (wave * 4 + it); gq[it][0] = *(const u32x4*)(GV + (size_t)r0 * SGW + col); gq[it][1] = *(const u32x4*)(GV + (size_t)(r0 + 1) * SGW + col); }
#pragma unroll
    for (int i = 0; i < 4; ++i) { const f32x4 w0 = wraw[2 * i], w1 = wraw[2 * i + 1]; const int s0 = 32 * sq + 8 * i;
        float e[8] = {w0[0], w0[1], w0[2], w0[3], w1[0], w1[1], w1[2], w1[3]};
#pragma unroll
        for (int j = 0; j < 8; ++j) e[j] = (s0 + j <= t_) ? e[j] : 0.f;
        u32x4 o; o.x = cvt_pk_bf16(e[0], e[1]); o.y = cvt_pk_bf16(e[2], e[3]); o.z = cvt_pk_bf16(e[4], e[5]); o.w = cvt_pk_bf16(e[6], e[7]);
        *(LAS u32x4*)(lds + MA_WT + t_ * MA_PITCH + s0 * 2) = o; }
    { const float mu0 = vs0 * (1.0f / SGW), mu1 = vs1 * (1.0f / SGW);
      const float rs0 = 1.0f / sqrtf(fmaxf(vq0 * (1.0f / SGW) - mu0 * mu0, 0.f) + EPS), rs1 = 1.0f / sqrtf(fmaxf(vq1 * (1.0f / SGW) - mu1 * mu1, 0.f) + EPS);
#pragma unroll
      for (int it = 0; it < 4; ++it) { const int cg = wave * 4 + it; const int col = C0 + 8 * cg;
          const u32x4 q0 = gq[it][0], q1 = gq[it][1];
          const f32x4 lg0 = *(const f32x4*)(a.in[3] + col), lg1 = *(const f32x4*)(a.in[3] + col + 4), lb0 = *(const f32x4*)(a.in[4] + col), lb1 = *(const f32x4*)(a.in[4] + col + 4);
          const float x0[8] = {bf_lo(q0.x), bf_hi(q0.x), bf_lo(q0.y), bf_hi(q0.y), bf_lo(q0.z), bf_hi(q0.z), bf_lo(q0.w), bf_hi(q0.w)};
          const float x1[8] = {bf_lo(q1.x), bf_hi(q1.x), bf_lo(q1.y), bf_hi(q1.y), bf_lo(q1.z), bf_hi(q1.z), bf_lo(q1.w), bf_hi(q1.w)};
          const float lg[8] = {lg0[0], lg0[1], lg0[2], lg0[3], lg1[0], lg1[1], lg1[2], lg1[3]}, lb[8] = {lb0[0], lb0[1], lb0[2], lb0[3], lb1[0], lb1[1], lb1[2], lb1[3]};
#pragma unroll
          for (int j = 0; j < 8; ++j) { const float n0 = (x0[j] - mu0) * rs0 * lg[j] + lb[j], n1 = (x1[j] - mu1) * rs1 * lg[j] + lb[j];
              *(LAS unsigned*)(lds + MA_VN + (8 * cg + j) * MA_PITCH + 4 * lane) = cvt_pk_bf16(n0, n1); } } }
    LDS_WAIT(); __syncthreads();
    const int fr = lane & 15, fq = lane >> 4;
    f32x4 acc[8][2];
#pragma unroll
    for (int m = 0; m < 8; ++m) { acc[m][0] = (f32x4){0.f, 0.f, 0.f, 0.f}; acc[m][1] = (f32x4){0.f, 0.f, 0.f, 0.f}; }
    u32x2 guv[8][2]; float bsv[8];
#pragma unroll
    for (int m = 0; m < 8; ++m) { bsv[m] = a.in[6][g * CHUNK + 16 * m + fr];
#pragma unroll
        for (int n = 0; n < 2; ++n) guv[m][n] = *(const u32x2*)(GU + (size_t)(R0 + 16 * m + fr) * SGW + C0 + 32 * wave + 16 * n + 4 * fq); }
#pragma unroll
    for (int ks = 0; ks < 4; ++ks) {
        bf16x8 vf[2];
#pragma unroll
        for (int n = 0; n < 2; ++n) vf[n] = *(const LAS bf16x8*)(lds + MA_VN + (32 * wave + 16 * n + fr) * MA_PITCH + (32 * ks + 8 * fq) * 2);
#pragma unroll
        for (int m = 0; m < 8; ++m) { if (32 * ks > 16 * m + 15) continue;
            const bf16x8 wf = *(const LAS bf16x8*)(lds + MA_WT + (16 * m + fr) * MA_PITCH + (32 * ks + 8 * fq) * 2);
#pragma unroll
            for (int n = 0; n < 2; ++n) acc[m][n] = __builtin_amdgcn_mfma_f32_16x16x32_bf16(vf[n], wf, acc[m][n], 0, 0, 0); }
    }
#pragma unroll
    for (int m = 0; m < 8; ++m) { const int t = 16 * m + fr; const float bs = bsv[m];
#pragma unroll
        for (int n = 0; n < 2; ++n) { const size_t offy = (size_t)(R0 + t) * LW + C0 + 32 * wave + 16 * n + 4 * fq; const u32x2 gu = guv[m][n];
            u32x2 o; o.x = cvt_pk_bf16(bf_lo(gu.x) * (acc[m][n][0] + bs), bf_hi(gu.x) * (acc[m][n][1] + bs)); o.y = cvt_pk_bf16(bf_lo(gu.y) * (acc[m][n][2] + bs), bf_hi(gu.y) * (acc[m][n][3] + bs));
            *(u32x2*)(YA + offy) = o; } }
    __syncthreads();
}

constexpr int MB_XPITCH = 528;
constexpr int MB_XC = 0, MB_AG = MBT * MB_XPITCH  , MB_CTAB = MB_AG + MBT * 65 * 8  , MB_CVT = MB_CTAB + 5 * 256 * 4  , MB_WX = MB_CVT + NWAVES * 32 * 17 * 4  ;
static_assert(MB_WX + 64 * MB_XPITCH <= MISC_OFF, "mixer B LDS map");
typedef float f32x2 __attribute__((ext_vector_type(2)));
__device__ __forceinline__ void mixer_b_unit(const Args& a, LAS unsigned char* lds, int unit) {
    const int tid = opaque_tid(), lane = tid & 63, wave = __builtin_amdgcn_readfirstlane(tid >> 6);
    unsigned char* ws = a.ws;
    const int q = unit & 3, hd = (unit >> 2) & 15, b = unit >> 6;
    const int HC = hd * LHD, OC = HC + 64 * q;
    const bf16* XR = (const bf16*)(ws + WS_XR); const bf16* GYR = (const bf16*)(ws + WS_GYR); bf16* YB = (bf16*)(ws + WS_YB);
    const bf16* WaT = (const bf16*)(ws + WS_WA) + (size_t)hd * LHD * LHD; const bf16* WxT = (const bf16*)(ws + WS_WX) + (size_t)hd * LHD * LHD;
    const int fr = lane & 15, fq = lane >> 4, cb = wave & 3, rh = wave >> 2;
    bf16x8 bfa[8];
#pragma unroll
    for (int ks = 0; ks < 8; ++ks) { const size_t o = (size_t)(64 * q + 16 * cb + fr) * LHD + 32 * ks + 8 * fq; bfa[ks] = *(const bf16x8*)(WaT + o); }
    { const int wrw = tid >> 3, wch = tid & 7;
#pragma unroll
      for (int i = 0; i < 4; ++i) *(LAS u32x4*)(lds + MB_WX + wrw * MB_XPITCH + (wch * 4 + i) * 16) = *(const u32x4*)(WxT + (size_t)(64 * q + wrw) * LHD + (wch * 4 + i) * 8); }
    float ba[4], bx[4], sp[4];
#pragma unroll
    for (int e = 0; e < 4; ++e) { const int col = OC + 16 * cb + 4 * fq + e; ba[e] = a.in[10][col]; bx[e] = a.in[12][col]; sp[e] = -8.0f * log1pf(expf(-a.in[13][col])); }
    const int cg = tid & 31, rg = tid >> 5;
    LAS float* ctab = (LAS float*)(lds + MB_CTAB);
    for (int i = tid; i < 5 * LHD; i += NWAVES * 64) { const int k = i >> 8, c = i & 255; ctab[i] = (k < 4) ? a.in[7][(size_t)k * LW + HC + c] : a.in[8][HC + c]; }
    LAS f32x2* ag = (LAS f32x2*)(lds + MB_AG);
    LAS unsigned* cscr = (LAS unsigned*)(lds + MB_CVT + wave * (32 * 17 * 4));
    const int c8 = lane & 7, rgp = lane >> 3;
    float carry = 0.f;
    const bf16* xrp = XR + ((size_t)b * SEQ + 4 * rg) * LW + HC + 8 * cg;
    u32x4 raw[7];
#pragma unroll
    for (int i = 0; i < 7; ++i) raw[i] = (4 * rg - 3 + i >= 0) ? *(const u32x4*)(xrp + (ptrdiff_t)(i - 3) * LW) : (u32x4){0u, 0u, 0u, 0u};
    const int sidu = (unit * MB_STEPS * NWAVES + wave) * CV_SLOTS;
    LDS_WAIT(); __syncthreads();
    for (int step = 0; step < MB_STEPS; ++step) {
        const int t0 = step * MBT; const size_t rowbase = (size_t)b * SEQ + t0;
        const bool more = step + 1 < MB_STEPS;
        { f32x4 cw[5][2];
#pragma unroll
          for (int k = 0; k < 5; ++k) { cw[k][0] = *(const LAS f32x4*)(ctab + k * LHD + 8 * cg); cw[k][1] = *(const LAS f32x4*)(ctab + k * LHD + 8 * cg + 4); }
#pragma unroll
          for (int r = 0; r < 4; ++r) { float o[8];
#pragma unroll
              for (int j = 0; j < 8; ++j) o[j] = cw[4][j >> 2][j & 3];
#pragma unroll
              for (int k = 0; k < 4; ++k) { const u32x4 w = raw[r + k];
                  o[0] += cw[k][0][0] * bf_lo(w.x); o[1] += cw[k][0][1] * bf_hi(w.x); o[2] += cw[k][0][2] * bf_lo(w.y); o[3] += cw[k][0][3] * bf_hi(w.y);
                  o[4] += cw[k][1][0] * bf_lo(w.z); o[5] += cw[k][1][1] * bf_hi(w.z); o[6] += cw[k][1][2] * bf_lo(w.w); o[7] += cw[k][1][3] * bf_hi(w.w); }
              u32x4 p; p.x = cvt_pk_bf16(o[0], o[1]); p.y = cvt_pk_bf16(o[2], o[3]); p.z = cvt_pk_bf16(o[4], o[5]); p.w = cvt_pk_bf16(o[6], o[7]);
              *(LAS u32x4*)(lds + MB_XC + (4 * rg + r) * MB_XPITCH + 16 * cg) = p; } }
        const size_t gb = (rowbase + 8 * rgp) * LW + OC + 8 * wave + c8;
        unsigned short yr[8];
#pragma unroll
        for (int i = 0; i < 8; ++i) yr[i] = GYR[gb + (size_t)i * LW];
        { const int tn = more ? t0 + MBT : t0;
#pragma unroll
          for (int i = 0; i < 7; ++i) raw[i] = *(const u32x4*)(xrp + (ptrdiff_t)(tn + i - 3) * LW); }
        f32x4 cvA[4], cvB[4]; float glA, glB;
        const int sid = sidu + step * NWAVES * CV_SLOTS;
        const CvtTile ctA = cvt_decode(a, sid), ctB = cvt_decode(a, sid + 1);
        cvt_issue(ctA, cvA, glA, lane); cvt_issue(ctB, cvB, glB, lane);
        LDS_BARRIER();
        { f32x4 ca[2], cx[2];
#pragma unroll
          for (int m = 0; m < 2; ++m) { ca[m] = (f32x4){0.f, 0.f, 0.f, 0.f}; cx[m] = (f32x4){0.f, 0.f, 0.f, 0.f}; }
#pragma unroll
          for (int ks = 0; ks < 8; ++ks)
#pragma unroll
              for (int m = 0; m < 2; ++m) { const bf16x8 af = *(const LAS bf16x8*)(lds + MB_XC + (32 * rh + 16 * m + fr) * MB_XPITCH + (32 * ks + 8 * fq) * 2);
                  const bf16x8 bxf = *(const LAS bf16x8*)(lds + MB_WX + (16 * cb + fr) * MB_XPITCH + (32 * ks + 8 * fq) * 2);
                  ca[m] = __builtin_amdgcn_mfma_f32_16x16x32_bf16(bfa[ks], af, ca[m], 0, 0, 0); cx[m] = __builtin_amdgcn_mfma_f32_16x16x32_bf16(bxf, af, cx[m], 0, 0, 0); }
#pragma unroll
          for (int m = 0; m < 2; ++m) { const int r = 32 * rh + 16 * m + fr; const int cl = 16 * cb + 4 * fq;
              const u32x2 xw = *(const LAS u32x2*)(lds + MB_XC + r * MB_XPITCH + (64 * q + cl) * 2);
              const float xv[4] = {bf_lo(xw.x), bf_hi(xw.x), bf_lo(xw.y), bf_hi(xw.y)};
#pragma unroll
              for (int e = 0; e < 4; ++e) { const float rgt = sigmoid_f(ca[m][e] + ba[e]), ig = sigmoid_f(cx[m][e] + bx[e]);
                  const float la = rgt * sp[e]; const float av = __builtin_amdgcn_exp2f(1.4426950409f * la);
                  const float y = 2.0f * la;
                  const float om = (y > -0.0625f) ? -y * (1.0f + y * (0.5f + y * (0.16666667f + y * 0.041666668f))) : (1.0f - av * av);
                  ag[r * 65 + cl + e] = (f32x2){av, __builtin_amdgcn_sqrtf(om) * ig * xv[e]}; } } }
        LDS_BARRIER();
        { f32x2 v[8]; float P = 1.f, Hh = 0.f;
#pragma unroll
          for (int i = 0; i < 8; ++i) { v[i] = ag[(8 * rgp + i) * 65 + 8 * wave + c8]; Hh = v[i].x * Hh + v[i].y; P *= v[i].x; }
#pragma unroll
          for (int d = 8; d < 64; d <<= 1) { const float Pp = __shfl_up(P, d), Hp = __shfl_up(Hh, d); if (lane >= d) { Hh = P * Hp + Hh; P = P * Pp; } }
          const float Pe = __shfl_up(P, 8), He = __shfl_up(Hh, 8);
          float c = (rgp == 0) ? carry : (Pe * carry + He);
          const float Pt = __shfl(P, 56 + c8), Ht = __shfl(Hh, 56 + c8);
          carry = Pt * carry + Ht;
#pragma unroll
          for (int i = 0; i < 8; ++i) { c = v[i].x * c + v[i].y; const float y = c * __uint_as_float((unsigned)yr[i] << 16); YB[gb + (size_t)i * LW] = (bf16)(cvt_pk_bf16(y, 0.f) & 0xffffu); } }
        cvt_finish(ctA, cvA, glA, cscr, lane); cvt_finish(ctB, cvB, glB, cscr, lane);
    }
    __syncthreads();
}

__device__ __forceinline__ void p6_fixup(const Args& a, int vcu, int G) {
    const int gt = vcu * (NWAVES * 64) + opaque_tid(), NT = G * NWAVES * 64;
    unsigned char* ws = a.ws; const float* HEAD = (const float*)(ws + WS_HEAD); const float* TAIL = (const float*)(ws + WS_TAIL); bf16* Gb = (bf16*)(ws + WS_G);
    const float* cw = a.in[19]; const float* cbv = a.in[20];
    for (int item = gt; item < 32 * 96 * 128; item += NT) {
        const int jj = item & 127, t = item >> 7, pn = t % 96, pm = t / 96; const int c = 128 * pn + jj;
        const float* hb = HEAD + ((size_t)(pm * 96 + pn) * 2) * 256;
        const float h0g = hb[jj], h1g = hb[256 + jj], h0v = hb[128 + jj], h1v = hb[256 + 128 + jj];
        float t0g = 0.f, t1g = 0.f, t0v = 0.f, t1v = 0.f;
        if (pm & 7) { const float* tb = TAIL + ((size_t)((pm - 1) * 96 + pn) * 2) * 256; t0g = tb[jj]; t1g = tb[256 + jj]; t0v = tb[128 + jj]; t1v = tb[256 + 128 + jj]; }
        const float wg0 = cw[c], wg1 = cw[UPN + c], wg2 = cw[2 * UPN + c], wv0 = cw[FFW + c], wv1 = cw[UPN + FFW + c], wv2 = cw[2 * UPN + FFW + c], bg = cbv[c], bv = cbv[FFW + c];
        const float g0 = bg + wg0 * t0g + wg1 * t1g + wg2 * h0g, v0 = bv + wv0 * t0v + wv1 * t1v + wv2 * h0v;
        const float g1 = bg + wg0 * t1g + wg1 * h0g + wg2 * h1g, v1 = bv + wv0 * t1v + wv1 * h0v + wv2 * h1v;
        Gb[(size_t)(256 * pm) * FFW + c] = (bf16)(cvt_pk_bf16(gelu_tanh_f(g0) * v0, 0.f) & 0xffffu);
        Gb[(size_t)(256 * pm + 1) * FFW + c] = (bf16)(cvt_pk_bf16(gelu_tanh_f(g1) * v1, 0.f) & 0xffffu);
    }
}

__device__ __forceinline__ void p8_final(const Args& a, int vcu, int G) {
    const int tid = opaque_tid(), lane = tid & 63, gw = vcu * NWAVES + __builtin_amdgcn_readfirstlane(tid >> 6), NGW = G * NWAVES;
    const float* rss = (const float*)(a.ws + WS_CTL) + CW_RSS3; const f32x4* gf = (const f32x4*)a.in[22] + lane;
    for (int m = gw; m < M; m += NGW) { const float rs = 1.0f / sqrtf(rss[m] * (1.0f / DM) + EPS); f32x4* o = (f32x4*)(a.out + (size_t)m * DM) + lane;
#pragma unroll
        for (int j = 0; j < 16; ++j) { const f32x4 v = o[64 * j], g = gf[64 * j]; o[64 * j] = v * rs * g; } }
}

__global__ void __launch_bounds__(NWAVES * 64, 2) hyb_fwd(Args args) {
    extern __shared__ __attribute__((aligned(16))) unsigned char lds_raw[];
    LAS unsigned char* lds = (LAS unsigned char*)lds_raw;
    volatile LAS unsigned* MISC = (volatile LAS unsigned*)(lds + MISC_OFF);
    const int tid = threadIdx.x;
    const int G = gridDim.x; const int bx = blockIdx.x; const int vcu = (G % 8 == 0) ? (bx % 8) * (G / 8) + bx / 8 : bx;
    unsigned char* ws = args.ws;
    unsigned* ctl = (unsigned*)(ws + WS_CTL);
    for (int u = tid; u < (LDS_BYTES - MISC_OFF) / 4; u += NWAVES * 64) ((LAS unsigned*)(lds + MISC_OFF))[u] = 0u;
    __syncthreads();
    XcdBarrier bar; bar.bar = ctl + CW_BAR; bar.x = 0; bar.st = nullptr;
    if (N_LAUNCHES == 1) bar = xcd_barrier_post(ctl + CW_BAR, MISC + 8);
#define GRID_BAR() do { if (N_LAUNCHES == 1) xcd_barrier(bar); } while (0)
    const int lo = args.ph_lo, hi = args.ph_hi;
#ifndef PH_MASK
#define PH_MASK 0x1ff
#endif
#ifndef REP_PH
#define REP_PH -1
#endif
#define NREP(k) ((REP_PH == (k)) ? 2 : 1)
#define IN(k) (((PH_MASK >> (k)) & 1) && lo <= (k) && (k) < hi)
#define BOTH(k) (IN(k) && IN((k) + 1))
    float* fctl = (float*)ctl;

    if (IN(0)) { for (int rep = 0; rep < NREP(0); ++rep) p0_prologue(args, lds, vcu, G); if (BOTH(0)) GRID_BAR(); }

    if (IN(1)) {
        pg8::Gemm g{(const bf16*)(ws + WS_H), (const bf16*)(ws + WS_WIN), M, INC, DM}; pg8::StaticOrder S; S.init(M, INC, G, bx);
        pg8::EpiProj E{(bf16*)(ws + WS_GU), (bf16*)(ws + WS_GV), (bf16*)(ws + WS_XR), (bf16*)(ws + WS_GYR), (bf16*)(ws + WS_SGA), (bf16*)(ws + WS_SGB), fctl + CW_VSUM, fctl + CW_VSQ};
        pg8::gemm_phase<pg8::EpiProj, pg8::StaticOrder, PG8_ALIGN, PG8_SP2>(lds, g, S, E);
        if (NREP(1) == 2) { pg8::EpiProj E2 = E; E2.vsum = fctl + CW_DUMMY; E2.vsq = fctl + CW_DUMMY + M; pg8::gemm_phase<pg8::EpiProj, pg8::StaticOrder, PG8_ALIGN, PG8_SP2>(lds, g, S, E2); }
        if (BOTH(1)) GRID_BAR();
    }

    if (IN(2)) {
        for (int rep = 0; rep < NREP(20); ++rep) for (int u = bx; u < NB * LH * 4; u += G) mixer_b_unit(args, lds, u);
        for (int rep = 0; rep < NREP(21); ++rep) for (int u = bx; u < NB * (SEQ / CHUNK) * 8; u += G) mixer_a_unit(args, lds, u);
        if (BOTH(2)) GRID_BAR();
    }

    if (IN(3)) {
        pg8::Gemm g1{(const bf16*)(ws + WS_YB), (const bf16*)(ws + WS_PB), M, DM, LW};
        pg8::StaticOrder S; S.init(M, DM, G, bx);
        pg8::EpiMerge E{(const bf16*)(ws + WS_SGA), (const bf16*)(ws + WS_SGB), (bf16*)(ws + WS_MRG)};
        pg8::gemm_phase_dual<pg8::EpiMerge, pg8::StaticOrder>(lds, g1, (const bf16*)(ws + WS_YA), (const bf16*)(ws + WS_PA), SGW, S, E);
        if (NREP(3) == 2) pg8::gemm_phase_dual<pg8::EpiMerge, pg8::StaticOrder>(lds, g1, (const bf16*)(ws + WS_YA), (const bf16*)(ws + WS_PA), SGW, S, E);
        if (BOTH(3)) GRID_BAR();
    }

    if (IN(4)) {
        pg8::Gemm g{(const bf16*)(ws + WS_MRG), (const bf16*)(ws + WS_WOUT), M, DM, DM}; pg8::StaticOrder S; S.init(M, DM, G, bx);
        pg8::EpiOut E{args.in[0], (bf16*)(ws + WS_X1B), fctl + CW_RSS2};
        pg8::gemm_phase<pg8::EpiOut, pg8::StaticOrder, PG8_ALIGN, PG8_SP2>(lds, g, S, E);
        if (NREP(4) == 2) { pg8::EpiOut E2 = E; E2.rowss = fctl + CW_DUMMY; pg8::gemm_phase<pg8::EpiOut, pg8::StaticOrder, PG8_ALIGN, PG8_SP2>(lds, g, S, E2); }
        if (BOTH(4)) GRID_BAR();
    }

    if (IN(5)) {
        pg8::Gemm g{(const bf16*)(ws + WS_X1B), (const bf16*)(ws + WS_WUP), M, UPN, DM}; pg8::StaticOrder S; S.init(M, UPN, G, bx);
        pg8::EpiUpGate E{(bf16*)(ws + WS_G), fctl + CW_RSS2, args.in[19], args.in[20], (float*)(ws + WS_HEAD), (float*)(ws + WS_TAIL), (LAS float*)(lds + HALO_OFF)};
        pg8::gemm_phase<pg8::EpiUpGate, pg8::StaticOrder, PG8_ALIGN, PG8_SP2>(lds, g, S, E);
        if (NREP(5) == 2) pg8::gemm_phase<pg8::EpiUpGate, pg8::StaticOrder, PG8_ALIGN, PG8_SP2>(lds, g, S, E);
        if (BOTH(5)) GRID_BAR();
    }

    if (IN(6)) { for (int rep = 0; rep < NREP(6); ++rep) p6_fixup(args, vcu, G); if (BOTH(6)) GRID_BAR(); }

    if (IN(7)) {
        pg8::Gemm g{(const bf16*)(ws + WS_G), (const bf16*)(ws + WS_WDN), M, DM, FFW}; pg8::StaticOrder S; S.init(M, DM, G, bx);
        pg8::EpiDown E{(const bf16*)(ws + WS_X1B), args.out, fctl + CW_RSS3};
        pg8::gemm_phase<pg8::EpiDown, pg8::StaticOrder, PG8_ALIGN, PG8_SP2>(lds, g, S, E);
        if (NREP(7) == 2) { pg8::EpiDown E2 = E; E2.rowss = fctl + CW_DUMMY; pg8::gemm_phase<pg8::EpiDown, pg8::StaticOrder, PG8_ALIGN, PG8_SP2>(lds, g, S, E2); }
        if (BOTH(7)) GRID_BAR();
    }

    if (IN(8)) p8_final(args, vcu, G);
#undef IN
#undef BOTH
#undef GRID_BAR
}

extern "C" void kernel_launch(void* const* d_in, const int* in_sizes, int n_in, void* d_out, int out_size, void* d_ws, size_t ws_size, hipStream_t stream) {
    static int grid = 0;
    if (grid == 0) {
        if (n_in != 23 || out_size != M * DM || ws_size < WS_END) { fprintf(stderr, "kernel_launch: unexpected shapes (n_in %d, out %d, ws %zu)\n", n_in, out_size, ws_size); grid = -1; return; }
        int dev = 0, cus = 0, per_cu = 0;
        if (hipGetDevice(&dev) != hipSuccess || hipDeviceGetAttribute(&cus, hipDeviceAttributeMultiprocessorCount, dev) != hipSuccess) { grid = -1; return; }
        if (hipFuncSetAttribute((const void*)hyb_fwd, hipFuncAttributeMaxDynamicSharedMemorySize, LDS_BYTES) != hipSuccess) { fprintf(stderr, "kernel_launch: hipFuncSetAttribute failed\n"); grid = -1; return; }
        if (hipOccupancyMaxActiveBlocksPerMultiprocessor(&per_cu, (const void*)hyb_fwd, NWAVES * 64, LDS_BYTES) != hipSuccess || per_cu < 1) { fprintf(stderr, "kernel_launch: occupancy query says %d\n", per_cu); }
        (void)hipGetLastError();
        grid = cus;
    }
    if (grid < 0) return;
    (void)in_sizes;
    (void)hipMemsetAsync((char*)d_ws + WS_CTL, 0, CTL_ZERO_BYTES, stream);
    Args a{};
    for (int i = 0; i < 23; ++i) a.in[i] = (const float*)d_in[i];
    a.out = (float*)d_out; a.ws = (unsigned char*)d_ws;
    if (N_LAUNCHES == 1) { a.ph_lo = 0; a.ph_hi = NPH; hipLaunchKernelGGL(hyb_fwd, dim3(grid), dim3(NWAVES * 64), LDS_BYTES, stream, a); }
    else for (int p = 0; p < NPH; ++p) { a.ph_lo = p; a.ph_hi = p + 1; hipLaunchKernelGGL(hyb_fwd, dim3(grid), dim3(NWAVES * 64), LDS_BYTES, stream, a); }
}
```
